# Optimizing an MI355X kernel written in HIP

```python
import jax, jax.numpy as jnp
from jax import lax
import numpy as np

D_MODEL = 1024
BATCH = 4
SEQ = 4096
DEPTH = 4

HEAD_DIM = 64
N_HEADS_TOTAL = D_MODEL // HEAD_DIM
N_MEM_HEADS = 4
N_MIX_HEADS = N_HEADS_TOTAL - N_MEM_HEADS
D_MIX = N_MIX_HEADS * HEAD_DIM
D_MEMQ = N_MEM_HEADS * HEAD_DIM
MEM_TOKENS = 256
D_FF = 2816
CONV_WIDTH = 3
ROPE_THETA = 10000.0
Q_BLOCK = 128
DILATED_BRANCHES = ((128, 1), (512, 4), (2048, 16))
N_MIXERS = 2
N_A_LAYERS = (DEPTH + 1) // 2
N_B_LAYERS = DEPTH // 2
FOX_IN = 3 * D_MIX + N_MIX_HEADS + D_MEMQ
DIL_IN = 3 * D_MIX + D_MEMQ
NORM_EPS = 1e-6
NEG = -1e30

kernel_name = 'hybrid_fox_dilated_memory_convffn'


def rmsnorm(x, g):
    xf = x.astype(jnp.float32)
    y = xf * lax.rsqrt(jnp.mean(xf * xf, axis=-1, keepdims=True) + NORM_EPS)
    return (y * g.astype(jnp.float32)).astype(x.dtype)


def split_heads(t, n_heads):
    b, s, _ = t.shape
    return t.reshape(b, s, n_heads, HEAD_DIM).transpose(0, 2, 1, 3)


def merge_heads(t):
    b, h, s, d = t.shape
    return t.transpose(0, 2, 1, 3).reshape(b, s, h * d)


def rope_tables(seq):
    inv = 1.0 / (ROPE_THETA ** (jnp.arange(0, HEAD_DIM, 2, dtype=jnp.float32) / HEAD_DIM))
    ang = jnp.arange(seq, dtype=jnp.float32)[:, None] * inv[None, :]
    return jnp.cos(ang), jnp.sin(ang)


def apply_rope(x, cos, sin):
    x1, x2 = jnp.split(x.astype(jnp.float32), 2, axis=-1)
    y = jnp.concatenate([x1 * cos - x2 * sin, x2 * cos + x1 * sin], axis=-1)
    return y.astype(x.dtype)


def fox_attention(q, k, v, log_f):
    b, h, s, dh = q.shape
    c = lax.cumsum(log_f, axis=2)
    nb = s // Q_BLOCK
    scale = dh ** -0.5
    qb = q.reshape(b, h, nb, Q_BLOCK, dh).transpose(2, 0, 1, 3, 4)
    cb = c.reshape(b, h, nb, Q_BLOCK).transpose(2, 0, 1, 3)
    starts = jnp.arange(nb, dtype=jnp.int32) * Q_BLOCK
    kpos = jnp.arange(s, dtype=jnp.int32)

    def one_block(args):
        qi, ci, st = args
        sc = jnp.einsum('bhqd,bhkd->bhqk', qi, k, preferred_element_type=jnp.float32) * scale
        sc = sc + ci[..., :, None] - c[..., None, :]
        qpos = st + jnp.arange(Q_BLOCK, dtype=jnp.int32)
        sc = jnp.where(kpos[None, :] <= qpos[:, None], sc, NEG)
        p = jax.nn.softmax(sc, axis=-1)
        return jnp.einsum('bhqk,bhkd->bhqd', p.astype(v.dtype), v)

    out = lax.map(one_block, (qb, cb, starts))
    return out.transpose(1, 2, 0, 3, 4).reshape(b, h, s, dh)


def dilated_branch(q, k, v, window, dilation):
    b, h, s, dh = q.shape
    L = window // dilation
    chunk = dilation * L
    sp = -(-s // chunk) * chunk
    n = sp // dilation
    nb = n // L
    scale = dh ** -0.5

    def strided(t):
        t = jnp.pad(t, ((0, 0), (0, 0), (0, sp - s), (0, 0)))
        t = t.reshape(b, h, n, dilation, dh).transpose(0, 1, 3, 2, 4)
        return t.reshape(b, h, dilation, nb, L, dh)

    def with_prev(t):
        prev = jnp.pad(t, ((0, 0), (0, 0), (0, 0), (1, 0), (0, 0), (0, 0)))[:, :, :, :-1]
        return jnp.concatenate([prev, t], axis=4)

    qs = strided(q)
    kb = with_prev(strided(k))
    vb = with_prev(strided(v))
    sc = jnp.einsum('bhrnqd,bhrnkd->bhrnqk', qs, kb, preferred_element_type=jnp.float32) * scale
    a = jnp.arange(L, dtype=jnp.int32)
    cidx = jnp.arange(2 * L, dtype=jnp.int32)
    blk = jnp.arange(nb, dtype=jnp.int32)
    dist = a[:, None] + L - cidx[None, :]
    valid = (dist >= 0) & (dist <= L)
    valid = valid[None] & ((blk[:, None, None] > 0) | (cidx[None, None, :] >= L))
    sc = jnp.where(valid, sc, NEG)
    m = jnp.max(sc, axis=-1, keepdims=True)
    e = jnp.exp(sc - m)
    den = jnp.sum(e, axis=-1, keepdims=True)
    o = jnp.einsum('bhrnqk,bhrnkd->bhrnqd', (e / den).astype(v.dtype), vb)
    lse = (m + jnp.log(den))[..., 0]
    o = o.reshape(b, h, dilation, n, dh).transpose(0, 1, 3, 2, 4).reshape(b, h, sp, dh)[:, :, :s]
    lse = lse.reshape(b, h, dilation, n).transpose(0, 1, 3, 2).reshape(b, h, sp)[:, :, :s]
    return o, lse


def dilated_attention(q, k, v):
    outs, lses = [], []
    for window, dilation in DILATED_BRANCHES:
        o, lse = dilated_branch(q, k, v, window, dilation)
        outs.append(o)
        lses.append(lse)
    wts = jax.nn.softmax(jnp.stack(lses, axis=0), axis=0)
    return jnp.einsum('gbhs,gbhsd->bhsd', wts.astype(v.dtype), jnp.stack(outs, axis=0))


def memory_attention(qm, mem_n, w_mem_kv):
    km, vm = jnp.split(mem_n @ w_mem_kv, 2, axis=-1)
    km = split_heads(km, N_MEM_HEADS)
    vm = split_heads(vm, N_MEM_HEADS)
    sc = jnp.einsum('bhqd,bhkd->bhqk', qm, km, preferred_element_type=jnp.float32) * (HEAD_DIM ** -0.5)
    p = jax.nn.softmax(sc, axis=-1)
    return jnp.einsum('bhqk,bhkd->bhqd', p.astype(vm.dtype), vm)


def conv_ffn(xn, w_up, conv_w, conv_b, w_down):
    u = xn @ w_up
    s = u.shape[1]
    up = jnp.pad(u, ((0, 0), (CONV_WIDTH - 1, 0), (0, 0)))
    c = conv_b
    for j in range(CONV_WIDTH):
        c = c + conv_w[j] * up[:, j:j + s]
    val, gate = jnp.split(c, 2, axis=-1)
    return (jax.nn.silu(gate) * val) @ w_down


def setup_inputs(seed: int = 0) -> dict:
    key = jax.random.key(seed)
    ks = jax.random.split(key, 16)
    f32 = jnp.float32
    nrm = lambda k, shape, scale: jax.random.normal(k, shape, f32) * scale
    forget_bias_init = 3.0
    return {
        'x': nrm(ks[0], (BATCH, SEQ, D_MODEL), 1.0),
        'mem': nrm(ks[1], (BATCH, MEM_TOKENS, D_MODEL), 1.0),
        'norm_mix': 1.0 + nrm(ks[2], (DEPTH, D_MODEL), 0.1),
        'norm_mem': 1.0 + nrm(ks[3], (DEPTH, D_MODEL), 0.1),
        'norm_ffn': 1.0 + nrm(ks[4], (DEPTH, D_MODEL), 0.1),
        'w_in_fox': nrm(ks[5], (N_A_LAYERS, D_MODEL, FOX_IN), D_MODEL ** -0.5),
        'b_forget': forget_bias_init + nrm(ks[6], (N_A_LAYERS, N_MIX_HEADS), 0.5),
        'w_in_dil': nrm(ks[7], (N_B_LAYERS, D_MODEL, DIL_IN), D_MODEL ** -0.5),
        'w_mem_kv': nrm(ks[8], (DEPTH, D_MODEL, 2 * D_MEMQ), D_MODEL ** -0.5),
        'w_out': nrm(ks[9], (DEPTH, D_MODEL, D_MODEL), D_MODEL ** -0.5),
        'w_up': nrm(ks[10], (DEPTH, D_MODEL, 2 * D_FF), D_MODEL ** -0.5),
        'conv_w': nrm(ks[11], (DEPTH, CONV_WIDTH, 2 * D_FF), CONV_WIDTH ** -0.5),
        'conv_b': nrm(ks[12], (DEPTH, 2 * D_FF), 0.02),
        'w_down': nrm(ks[13], (DEPTH, D_FF, D_MODEL), D_FF ** -0.5),
        'norm_final': 1.0 + nrm(ks[14], (D_MODEL,), 0.1),
    }


def reference(x, mem, norm_mix, norm_mem, norm_ffn, w_in_fox, b_forget, w_in_dil,
              w_mem_kv, w_out, w_up, conv_w, conv_b, w_down, norm_final):
    s = x.shape[1]
    cos, sin = rope_tables(s)
    h = x
    for layer in range(DEPTH):
        kind = layer % N_MIXERS
        slot = layer // N_MIXERS
        xn = rmsnorm(h, norm_mix[layer])
        mn = rmsnorm(mem, norm_mem[layer])
        if kind == 0:
            proj = xn @ w_in_fox[slot]
            q, k, v, f_logit, qm = jnp.split(
                proj, [D_MIX, 2 * D_MIX, 3 * D_MIX, 3 * D_MIX + N_MIX_HEADS], axis=-1)
            log_f = jax.nn.log_sigmoid(
                (f_logit + b_forget[slot]).astype(jnp.float32)).transpose(0, 2, 1)
            mix = fox_attention(split_heads(q, N_MIX_HEADS), split_heads(k, N_MIX_HEADS),
                                split_heads(v, N_MIX_HEADS), log_f)
        else:
            proj = xn @ w_in_dil[slot]
            q, k, v, qm = jnp.split(proj, [D_MIX, 2 * D_MIX, 3 * D_MIX], axis=-1)
            qh = apply_rope(split_heads(q, N_MIX_HEADS), cos, sin)
            kh = apply_rope(split_heads(k, N_MIX_HEADS), cos, sin)
            mix = dilated_attention(qh, kh, split_heads(v, N_MIX_HEADS))
        mem_out = memory_attention(split_heads(qm, N_MEM_HEADS), mn, w_mem_kv[layer])
        heads = jnp.concatenate([mix, mem_out], axis=1)
        h = h + merge_heads(heads) @ w_out[layer]
        h = h + conv_ffn(rmsnorm(h, norm_ffn[layer]), w_up[layer], conv_w[layer],
                         conv_b[layer], w_down[layer])
    return rmsnorm(h, norm_final)
```

```cpp
#include <hip/hip_runtime.h>
#include <cstdio>
#include <cstdint>
#include <cmath>

namespace v1 {
constexpr int D = 1024, B = 4, S = 4096, M = B * S, DEPTH = 4, HD = 64, NMIX = 12, NMEMH = 4, DMIX = 768, DMEMQ = 256;
constexpr int MEMT = 256, FF = 2816, FF2 = 2 * FF, FOX_IN = 3 * DMIX + NMIX + DMEMQ, DIL_IN = 3 * DMIX + DMEMQ;
constexpr float EPS = 1e-6f;

__global__ __launch_bounds__(256) void k_rmsnorm(const float* in, const float* g, float* out, int rows) {
    const int row = blockIdx.x * 4 + (threadIdx.x >> 6), lane = threadIdx.x & 63;
    if (row >= rows) return;
    const float4* xr = (const float4*)(in + (size_t)row * D) + lane;
    float4 v[4]; float s = 0.f;
#pragma unroll
    for (int j = 0; j < 4; ++j) { v[j] = xr[64 * j]; s += v[j].x * v[j].x + v[j].y * v[j].y + v[j].z * v[j].z + v[j].w * v[j].w; }
#pragma unroll
    for (int o = 1; o < 64; o <<= 1) s += __shfl_xor(s, o);
    const float r = 1.0f / sqrtf(s * (1.0f / D) + EPS);
    float4* orow = (float4*)(out + (size_t)row * D) + lane; const float4* gr = (const float4*)g + lane;
#pragma unroll
    for (int j = 0; j < 4; ++j) { const float4 gg = gr[64 * j]; float4 o4; o4.x = v[j].x * r * gg.x; o4.y = v[j].y * r * gg.y; o4.z = v[j].z * r * gg.z; o4.w = v[j].w * r * gg.w; orow[64 * j] = o4; }
}

template <bool ACC>
__global__ __launch_bounds__(256) void k_sgemm(const float* __restrict__ A, int lda, const float* __restrict__ Bm, int ldb, float* __restrict__ C, int ldc, int N, int K) {
    __shared__ float As[8][132];
    __shared__ float Bs[8][132];
    const int tid = threadIdx.x, tx = tid & 15, ty = tid >> 4;
    const int bm = blockIdx.y * 128, bn = blockIdx.x * 128;
    float acc[8][8];
#pragma unroll
    for (int i = 0; i < 8; ++i)
#pragma unroll
        for (int j = 0; j < 8; ++j) acc[i][j] = 0.f;
    const int ar = tid >> 1, ak = (tid & 1) * 4;
    const int bk = tid >> 5, bc = (tid & 31) * 4;
    const float* Ap = A + (size_t)(bm + ar) * lda + ak;
    const bool bok = (bn + bc) < N;
    const float* Bp = Bm + (size_t)bk * ldb + bn + bc;
    for (int k0 = 0; k0 < K; k0 += 8) {
        const float4 a = *(const float4*)(Ap + k0);
        float4 b = make_float4(0.f, 0.f, 0.f, 0.f);
        if (bok) b = *(const float4*)(Bp + (size_t)k0 * ldb);
        As[ak + 0][ar] = a.x; As[ak + 1][ar] = a.y; As[ak + 2][ar] = a.z; As[ak + 3][ar] = a.w;
        *(float4*)&Bs[bk][bc] = b;
        __syncthreads();
#pragma unroll
        for (int kk = 0; kk < 8; ++kk) {
            float av[8], bv[8];
            const float4 a0 = *(const float4*)&As[kk][ty * 4], a1 = *(const float4*)&As[kk][64 + ty * 4];
            const float4 b0 = *(const float4*)&Bs[kk][tx * 4], b1 = *(const float4*)&Bs[kk][64 + tx * 4];
            av[0] = a0.x; av[1] = a0.y; av[2] = a0.z; av[3] = a0.w; av[4] = a1.x; av[5] = a1.y; av[6] = a1.z; av[7] = a1.w;
            bv[0] = b0.x; bv[1] = b0.y; bv[2] = b0.z; bv[3] = b0.w; bv[4] = b1.x; bv[5] = b1.y; bv[6] = b1.z; bv[7] = b1.w;
#pragma unroll
            for (int i = 0; i < 8; ++i)
#pragma unroll
                for (int j = 0; j < 8; ++j) acc[i][j] = fmaf(av[i], bv[j], acc[i][j]);
        }
        __syncthreads();
    }
#pragma unroll
    for (int i = 0; i < 8; ++i) {
        const int row = bm + (i < 4 ? ty * 4 + i : 64 + ty * 4 + (i - 4));
#pragma unroll
        for (int jh = 0; jh < 2; ++jh) {
            const int col = bn + jh * 64 + tx * 4;
            if (col < N) {
                float4* cp = (float4*)(C + (size_t)row * ldc + col);
                float4 o = make_float4(acc[i][jh * 4 + 0], acc[i][jh * 4 + 1], acc[i][jh * 4 + 2], acc[i][jh * 4 + 3]);
                if (ACC) { const float4 old = *cp; o.x += old.x; o.y += old.y; o.z += old.z; o.w += old.w; }
                *cp = o;
            }
        }
    }
}

__device__ __forceinline__ float logsig(float x) { return fminf(x, 0.f) - log1pf(expf(-fabsf(x))); }

__global__ __launch_bounds__(256) void k_foxc(const float* __restrict__ proj, const float* __restrict__ bf, float* __restrict__ c) {
    __shared__ float sh[256];
    const int bh = blockIdx.x, b = bh / NMIX, h = bh % NMIX, tid = threadIdx.x;
    float v[16]; float s = 0.f;
#pragma unroll
    for (int i = 0; i < 16; ++i) { const int t = tid * 16 + i; const float x = proj[(size_t)(b * S + t) * FOX_IN + 3 * DMIX + h] + bf[h]; s += logsig(x); v[i] = s; }
    sh[tid] = s; __syncthreads();
    for (int off = 1; off < 256; off <<= 1) { const float tmp = tid >= off ? sh[tid - off] : 0.f; __syncthreads(); sh[tid] += tmp; __syncthreads(); }
    const float base = tid ? sh[tid - 1] : 0.f;
#pragma unroll
    for (int i = 0; i < 16; ++i) c[(size_t)bh * S + tid * 16 + i] = base + v[i];
}

__global__ __launch_bounds__(256) void k_fox(const float* __restrict__ proj, const float* __restrict__ c, float* __restrict__ heads) {
    const int t = blockIdx.x * 256 + threadIdx.x, h = blockIdx.y, b = blockIdx.z;
    const float* qp = proj + (size_t)(b * S + t) * FOX_IN + h * HD;
    float q[64], o[64];
#pragma unroll
    for (int i = 0; i < 64; ++i) { q[i] = qp[i] * 0.125f; o[i] = 0.f; }
    const float* cb = c + (size_t)(b * NMIX + h) * S;
    const float ct = cb[t];
    float m = -INFINITY, l = 0.f;
    const int tmax = blockIdx.x * 256 + 255;
    for (int s = 0; s <= tmax; ++s) {
        const float* kp = proj + (size_t)(b * S + s) * FOX_IN + DMIX + h * HD;
        const float* vp = kp + DMIX;
        float sc = 0.f;
#pragma unroll
        for (int i = 0; i < 64; ++i) sc = fmaf(q[i], kp[i], sc);
        sc += ct - cb[s];
        if (s > t) sc = -1e30f;
        const float mn = fmaxf(m, sc), al = __expf(m - mn), p = __expf(sc - mn);
        l = l * al + p; m = mn;
#pragma unroll
        for (int i = 0; i < 64; ++i) o[i] = fmaf(p, vp[i], o[i] * al);
    }
    float* op = heads + (size_t)(b * S + t) * D + h * HD; const float il = 1.0f / l;
#pragma unroll
    for (int i = 0; i < 64; ++i) op[i] = o[i] * il;
}

__global__ __launch_bounds__(256) void k_rope(float* __restrict__ proj) {
    const size_t idx = (size_t)blockIdx.x * 256 + threadIdx.x;
    const int i = idx & 31; const int hh = (idx >> 5) % 24; const size_t row = idx / (24 * 32);
    const int pos = (int)(row % S);
    const float inv = (float)exp(-(double)(2 * i) / 64.0 * log(10000.0));
    const float ang = (float)pos * inv;
    float sn, cs; sincosf(ang, &sn, &cs);
    float* p = proj + row * DIL_IN + hh * HD;
    const float x1 = p[i], x2 = p[i + 32];
    p[i] = x1 * cs - x2 * sn; p[i + 32] = x2 * cs + x1 * sn;
}

__global__ __launch_bounds__(256) void k_dil(const float* __restrict__ proj, float* __restrict__ heads) {
    const int t = blockIdx.x * 256 + threadIdx.x, h = blockIdx.y, b = blockIdx.z;
    const float* qp = proj + (size_t)(b * S + t) * DIL_IN + h * HD;
    float q[64], o[64];
#pragma unroll
    for (int i = 0; i < 64; ++i) { q[i] = qp[i] * 0.125f; o[i] = 0.f; }
    float m = -INFINITY, l = 0.f;
    for (int g = 0; g < 3; ++g) {
        const int d = g == 0 ? 1 : (g == 1 ? 4 : 16);
        for (int kk = 0; kk <= 128; ++kk) {
            const int pos = t - kk * d;
            if (pos >= 0) {
                const float* kp = proj + (size_t)(b * S + pos) * DIL_IN + DMIX + h * HD;
                const float* vp = kp + DMIX;
                float sc = 0.f;
#pragma unroll
                for (int i = 0; i < 64; ++i) sc = fmaf(q[i], kp[i], sc);
                const float mn = fmaxf(m, sc), al = __expf(m - mn), p = __expf(sc - mn);
                l = l * al + p; m = mn;
#pragma unroll
                for (int i = 0; i < 64; ++i) o[i] = fmaf(p, vp[i], o[i] * al);
            }
        }
    }
    float* op = heads + (size_t)(b * S + t) * D + h * HD; const float il = 1.0f / l;
#pragma unroll
    for (int i = 0; i < 64; ++i) op[i] = o[i] * il;
}

__global__ __launch_bounds__(256) void k_memattn(const float* __restrict__ proj, int ldp, int qoff, const float* __restrict__ kvm, float* __restrict__ heads) {
    const int t = blockIdx.x * 256 + threadIdx.x, hm = blockIdx.y, b = blockIdx.z;
    const float* qp = proj + (size_t)(b * S + t) * ldp + qoff + hm * HD;
    float q[64], o[64];
#pragma unroll
    for (int i = 0; i < 64; ++i) { q[i] = qp[i] * 0.125f; o[i] = 0.f; }
    float m = -INFINITY, l = 0.f;
    for (int j = 0; j < MEMT; ++j) {
        const float* kp = kvm + (size_t)(b * MEMT + j) * (2 * DMEMQ) + hm * HD;
        const float* vp = kp + DMEMQ;
        float sc = 0.f;
#pragma unroll
        for (int i = 0; i < 64; ++i) sc = fmaf(q[i], kp[i], sc);
        const float mn = fmaxf(m, sc), al = __expf(m - mn), p = __expf(sc - mn);
        l = l * al + p; m = mn;
#pragma unroll
        for (int i = 0; i < 64; ++i) o[i] = fmaf(p, vp[i], o[i] * al);
    }
    float* op = heads + (size_t)(b * S + t) * D + DMIX + hm * HD; const float il = 1.0f / l;
#pragma unroll
    for (int i = 0; i < 64; ++i) op[i] = o[i] * il;
}

__global__ __launch_bounds__(256) void k_convglu(const float* __restrict__ u, const float* __restrict__ cw, const float* __restrict__ cb, float* __restrict__ act) {
    const size_t idx = (size_t)blockIdx.x * 256 + threadIdx.x;
    const int f = (int)(idx % FF); const int t = (int)(idx / FF);
    float val = cb[f], gate = cb[FF + f];
#pragma unroll
    for (int j = 0; j < 3; ++j) { const int tt = t - 2 + j; if (tt >= 0) { val = fmaf(cw[j * FF2 + f], u[(size_t)tt * FF2 + f], val); gate = fmaf(cw[j * FF2 + FF + f], u[(size_t)tt * FF2 + FF + f], gate); } }
    act[(size_t)t * FF + f] = gate / (1.0f + __expf(-gate)) * val;
}
}

extern "C" void kernel_launch(void* const* d_in, const int* in_sizes, int n_in, void* d_out, int out_size, void* d_ws, size_t ws_size, hipStream_t stream) {
    using namespace v1;
    const float* x = (const float*)d_in[0]; const float* mem = (const float*)d_in[1];
    const float* norm_mix = (const float*)d_in[2]; const float* norm_mem = (const float*)d_in[3]; const float* norm_ffn = (const float*)d_in[4];
    const float* w_in_fox = (const float*)d_in[5]; const float* b_forget = (const float*)d_in[6]; const float* w_in_dil = (const float*)d_in[7];
    const float* w_mem_kv = (const float*)d_in[8]; const float* w_out = (const float*)d_in[9]; const float* w_up = (const float*)d_in[10];
    const float* conv_w = (const float*)d_in[11]; const float* conv_b = (const float*)d_in[12]; const float* w_down = (const float*)d_in[13]; const float* norm_final = (const float*)d_in[14];
    float* h = (float*)d_out;
    const size_t MiB = 1u << 20;
    char* ws = (char*)d_ws;
    float* XN = (float*)(ws);
    float* PROJ = (float*)(ws + 64 * MiB);
    float* U = PROJ; float* ACT = (float*)(ws + (64 + 88) * MiB);
    float* MN = (float*)(ws + 226 * MiB); float* KVM = (float*)(ws + 230 * MiB); float* CC = (float*)(ws + 232 * MiB);
    if (ws_size < 234 * MiB) { fprintf(stderr, "workspace too small\n"); return; }
    hipMemcpyAsync(h, x, (size_t)M * D * 4, hipMemcpyDeviceToDevice, stream);
    for (int layer = 0; layer < DEPTH; ++layer) {
        const int kind = layer & 1, slot = layer >> 1;
        k_rmsnorm<<<M / 4, 256, 0, stream>>>(h, norm_mix + layer * D, XN, M);
        k_rmsnorm<<<B * MEMT / 4, 256, 0, stream>>>(mem, norm_mem + layer * D, MN, B * MEMT);
        const int NIN = kind == 0 ? FOX_IN : DIL_IN;
        const float* win = kind == 0 ? w_in_fox + (size_t)slot * D * FOX_IN : w_in_dil + (size_t)slot * D * DIL_IN;
        k_sgemm<false><<<dim3((NIN + 127) / 128, M / 128), 256, 0, stream>>>(XN, D, win, NIN, PROJ, NIN, NIN, D);
        k_sgemm<false><<<dim3(4, B * MEMT / 128), 256, 0, stream>>>(MN, D, w_mem_kv + (size_t)layer * D * 512, 512, KVM, 512, 512, D);
        float* HEADS = XN;
        if (kind == 0) {
            k_foxc<<<B * NMIX, 256, 0, stream>>>(PROJ, b_forget + slot * NMIX, CC);
            k_fox<<<dim3(S / 256, NMIX, B), 256, 0, stream>>>(PROJ, CC, HEADS);
            k_memattn<<<dim3(S / 256, NMEMH, B), 256, 0, stream>>>(PROJ, FOX_IN, 3 * DMIX + NMIX, KVM, HEADS);
        } else {
            k_rope<<<(unsigned)((size_t)M * 24 * 32 / 256), 256, 0, stream>>>(PROJ);
            k_dil<<<dim3(S / 256, NMIX, B), 256, 0, stream>>>(PROJ, HEADS);
            k_memattn<<<dim3(S / 256, NMEMH, B), 256, 0, stream>>>(PROJ, DIL_IN, 3 * DMIX, KVM, HEADS);
        }
        k_sgemm<true><<<dim3(D / 128, M / 128), 256, 0, stream>>>(HEADS, D, w_out + (size_t)layer * D * D, D, h, D, D, D);
        k_rmsnorm<<<M / 4, 256, 0, stream>>>(h, norm_ffn + layer * D, XN, M);
        for (int b = 0; b < B; ++b) {
            k_sgemm<false><<<dim3(FF2 / 128, S / 128), 256, 0, stream>>>(XN + (size_t)b * S * D, D, w_up + (size_t)layer * D * FF2, FF2, U, FF2, FF2, D);
            k_convglu<<<(unsigned)((size_t)S * FF / 256), 256, 0, stream>>>(U, conv_w + (size_t)layer * 3 * FF2, conv_b + (size_t)layer * FF2, ACT);
            k_sgemm<true><<<dim3(D / 128, S / 128), 256, 0, stream>>>(ACT, FF, w_down + (size_t)layer * FF * D, D, h + (size_t)b * S * D, D, D, FF);
        }
    }
    k_rmsnorm<<<M / 4, 256, 0, stream>>>(h, norm_final, h, M);
}
```

```cpp
#include <hip/hip_runtime.h>
#include <hip/hip_bf16.h>
#include <cstdio>
#include <cstdint>
#include <cmath>

constexpr int NWAVES = 8;
constexpr int BATCH = 4, SEQ = 4096, DMODEL = 1024, MTOK = BATCH * SEQ, DEPTH = 4, NMIX = 12, FFD = 2816, FF2 = 2 * FFD, MEMT = 256;
constexpr int FOX_IN = 2572, DIL_IN = 2560;
constexpr size_t MiB = 1u << 20;
constexpr size_t WS_CTL = 0, CTL_ZERO_BYTES = 1 * MiB;
constexpr size_t WS_ROPE = 1 * MiB;
constexpr size_t WS_SSQA = 2 * MiB, WS_SSQB = 2 * MiB + 256 * 1024;
constexpr size_t WS_RMEM = 2 * MiB + 512 * 1024;
constexpr size_t WS_FLOG = 3 * MiB;
constexpr size_t WS_LSE4 = 4 * MiB, WS_LSE16 = 5 * MiB;
constexpr size_t WS_MEMB = 6 * MiB;
constexpr size_t WS_KVM = 8 * MiB;
constexpr size_t WS_WIN = 12 * MiB, WIN_STRIDE = (size_t)2816 * 1024 * 2;
constexpr size_t WS_WOUT = 34 * MiB, WOUT_STRIDE = (size_t)1024 * 1024 * 2;
constexpr size_t WS_WUP = 42 * MiB;
constexpr size_t WS_WDN = 53 * MiB;
constexpr size_t WS_WMKV = 59 * MiB;
constexpr size_t WS_HB = 64 * MiB;
constexpr size_t WS_OB4 = WS_HB + 4096;
constexpr size_t WS_QO = 97 * MiB, WS_K = 129 * MiB, WS_V = 153 * MiB;
constexpr size_t WS_ACT = 97 * MiB;
constexpr size_t WS_OB16 = 185 * MiB;
constexpr size_t WS_END = 209 * MiB;
static_assert(WS_HB + (size_t)(2 + MTOK + 256) * 2048 <= WS_QO && WS_ACT + (size_t)MTOK * FFD * 2 <= WS_OB16 && WS_V + (size_t)MTOK * 768 * 2 <= WS_OB16, "d_ws map");
constexpr int CW_TMO = 0, CW_CODE = 1, CW_BAR = 4096;

__device__ __forceinline__ int opaque_tid() { int t = threadIdx.x; asm volatile("" : "+v"(t)); return t; }
__device__ __forceinline__ int opaque_zero() { int z = 0; asm volatile("" : "+s"(z)); return z; }

namespace pg8 {
#define PG8_LAS __attribute__((address_space(3)))
typedef unsigned short bf16_t;
typedef short bf16x8 __attribute__((ext_vector_type(8)));
typedef float f32x4 __attribute__((ext_vector_type(4)));
typedef unsigned u32x4 __attribute__((ext_vector_type(4)));
constexpr int BM = 256, BK = 64, HALF = 128, HTB = HALF * BK * 2  , STAGE_BYTES = 8 * HTB, NXCD = 8, WGM = 8;

__host__ __device__ __forceinline__ int lds_byte(int r, int c) { const int st = (r >> 4) * 2 + (c >> 5), rr = r & 15, cc = c & 31, ob = rr * 64 + cc * 2; return st * 1024 + (ob ^ (((ob >> 9) & 1) << 5)); }
__host__ __device__ __forceinline__ void stage_rc(int b, int& R, int& C) { const int st = b / 1024, sb = b % 1024, swz = sb ^ (((sb >> 9) & 1) << 5); R = (st >> 1) * 16 + swz / 64; C = (st & 1) * 32 + (swz % 64) / 2; }
__host__ __device__ __forceinline__ int perm32(int rho) { const int n = rho >> 4, i = rho & 15; return 8 * (i >> 2) + 4 * n + (i & 3); }

constexpr int MROWS = 16384;
struct Unit { int pm, pn; };
struct Gemm { const bf16_t* A; const bf16_t* Bt; int K; int halo;
    __device__ __forceinline__ int arow(int R) const { return halo ? 62 * (R >> 6) + (R & 63) : R; }
    __device__ __forceinline__ int arow_half() const { return halo ? 124 : 128; }
    __device__ __forceinline__ size_t a_off(int pm) const { return halo ? (size_t)((pm / 17) * 4096 + 248 * (pm % 17)) * (size_t)K * 2 : (size_t)pm * 256 * (size_t)K * 2; }
};
struct StaticOrder {
    int nM, nN, nwg, G, c;
    __host__ __device__ void init(int nM_, int nN_, int G_, int c_) { nM = nM_; nN = nN_; nwg = nM * nN; G = G_; c = c_; }
    __host__ __device__ bool next(int i, Unit& u) const {
        const long L = (long)i * G + c; if (L >= nwg) return false;
        int wgid = (int)L; { const int q = nwg / NXCD, r = nwg % NXCD, xcd = wgid % NXCD, off = wgid / NXCD; wgid = (xcd < r ? xcd * (q + 1) : r * (q + 1) + (xcd - r) * q) + off; }
        const int nig = WGM * nN, gid = wgid / nig, fm = gid * WGM, gsz = (nM - fm) < WGM ? (nM - fm) : WGM;
        u.pm = fm + ((wgid % nig) % gsz); u.pn = (wgid % nig) / gsz; return true;
    }
    __device__ __forceinline__ void a_ready(const Unit&) const {}
    __device__ __forceinline__ void done(const Unit&) const {}
};

__device__ __forceinline__ unsigned cvt_pk_bf16(float lo, float hi) { unsigned r; asm volatile("v_cvt_pk_bf16_f32 %0, %1, %2" : "=v"(r) : "v"(lo), "v"(hi)); return r; }
typedef float f32x2 __attribute__((ext_vector_type(2)));
typedef unsigned u32x2 __attribute__((ext_vector_type(2)));
constexpr float QSCALE = 0.125f * 1.4426950408889634f;
__device__ __forceinline__ float row_rstd(const float* ssq, int row) {
    const float s = (ssq[row] + ssq[MROWS + row]) + (ssq[2 * MROWS + row] + ssq[3 * MROWS + row]);
    return 1.0f / sqrtf(s * (1.0f / 1024.0f) + 1e-6f);
}
__device__ __forceinline__ float logsig(float x) { return fminf(x, 0.f) - log1pf(expf(-fabsf(x))); }

struct EpiInProj {
    static constexpr bool PERM = true, AFTER_DRAIN = false;
    bf16_t *Q, *Kb, *Vb; float* flog; const float* ssq; const float* bfor; const float* rope; int dil;
    __device__ __forceinline__ void operator()(const f32x4 (&acc)[2][2][4][2], const Unit& u, int wr, int wc, int fr, int fq) const {
        const int row0 = u.pm * BM + wr * 64 + fr, pn = u.pn;
        if (pn == 10) {
            if (wc == 0) {
#pragma unroll
                for (int ai = 0; ai < 2; ++ai)
#pragma unroll
                    for (int m = 0; m < 4; ++m) { const int row = row0 + ai * HALF + m * 16; const float rt = row_rstd(ssq, row); const int b = row >> 12, s = row & 4095;
                        const f32x4 v0 = acc[ai][0][m][0], v1 = acc[ai][0][m][1];
                        if (fq == 0) {
#pragma unroll
                            for (int e = 0; e < 4; ++e) { flog[(size_t)(b * 12 + e) * 4096 + s] = logsig(v0[e] * rt + bfor[e]); flog[(size_t)(b * 12 + 4 + e) * 4096 + s] = logsig(v1[e] * rt + bfor[4 + e]); }
                        } else if (fq == 1) {
#pragma unroll
                            for (int e = 0; e < 4; ++e) flog[(size_t)(b * 12 + 8 + e) * 4096 + s] = logsig(v0[e] * rt + bfor[8 + e]);
                        } }
            }
            return;
        }
        bf16_t* base; int ldc, colt; float sc = 1.f; bool rp;
        if (pn < 4) { base = Q; ldc = 1024; colt = pn * 256; sc = QSCALE; rp = dil && pn < 3; }
        else if (pn < 7) { base = Kb; ldc = 768; colt = (pn - 4) * 256; rp = dil != 0; }
        else { base = Vb; ldc = 768; colt = (pn - 7) * 256; rp = false; }
        const int col0 = colt + wc * 32 + 8 * fq, i0 = (16 * wc + 4 * fq) & 31;
#pragma unroll
        for (int ai = 0; ai < 2; ++ai)
#pragma unroll
            for (int m = 0; m < 4; ++m) { const int row = row0 + ai * HALF + m * 16; const float rt = row_rstd(ssq, row) * sc; const int pos = row & 4095;
                f32x4 cs = (f32x4){1.f, 1.f, 1.f, 1.f}, sn = (f32x4){0.f, 0.f, 0.f, 0.f};
                if (rp) { cs = *(const f32x4*)(rope + pos * 32 + i0); sn = *(const f32x4*)(rope + 4096 * 32 + pos * 32 + i0); }
                bf16_t* rowp = base + (size_t)row * ldc + col0;
#pragma unroll
                for (int bj = 0; bj < 2; ++bj) { f32x4 v0 = acc[ai][bj][m][0] * rt, v1 = acc[ai][bj][m][1] * rt;
                    if (rp) { const f32x4 a = v0, b = v1;
                        v0[0] = a[0] * cs[0] - a[1] * sn[0]; v0[1] = a[1] * cs[0] + a[0] * sn[0]; v0[2] = a[2] * cs[1] - a[3] * sn[1]; v0[3] = a[3] * cs[1] + a[2] * sn[1];
                        v1[0] = b[0] * cs[2] - b[1] * sn[2]; v1[1] = b[1] * cs[2] + b[0] * sn[2]; v1[2] = b[2] * cs[3] - b[3] * sn[3]; v1[3] = b[3] * cs[3] + b[2] * sn[3]; }
                    u32x4 w; w.x = cvt_pk_bf16(v0[0], v0[1]); w.y = cvt_pk_bf16(v0[2], v0[3]); w.z = cvt_pk_bf16(v1[0], v1[1]); w.w = cvt_pk_bf16(v1[2], v1[3]);
                    *(u32x4*)(rowp + bj * HALF) = w; } }
    }
};
struct EpiMemKV {
    static constexpr bool PERM = true, AFTER_DRAIN = false;
    bf16_t* O; const float* rmem;
    __device__ __forceinline__ void operator()(const f32x4 (&acc)[2][2][4][2], const Unit& u, int wr, int wc, int fr, int fq) const {
        const int row0 = u.pm * BM + wr * 64 + fr, col0 = u.pn * BM + wc * 32 + 8 * fq;
#pragma unroll
        for (int ai = 0; ai < 2; ++ai)
#pragma unroll
            for (int m = 0; m < 4; ++m) { const int row = row0 + ai * HALF + m * 16; const float rt = rmem[row]; bf16_t* rowp = O + (size_t)row * 2048 + col0;
#pragma unroll
                for (int bj = 0; bj < 2; ++bj) { const f32x4 v0 = acc[ai][bj][m][0] * rt, v1 = acc[ai][bj][m][1] * rt;
                    u32x4 w; w.x = cvt_pk_bf16(v0[0], v0[1]); w.y = cvt_pk_bf16(v0[2], v0[3]); w.z = cvt_pk_bf16(v1[0], v1[1]); w.w = cvt_pk_bf16(v1[2], v1[3]);
                    *(u32x4*)(rowp + bj * HALF) = w; } }
    }
};
struct EpiResid {
    static constexpr bool PERM = false, AFTER_DRAIN = true;
    float* h; bf16_t* hb; float* ssq;
    __device__ __forceinline__ void fused(const f32x4 (&acc)[2][2][4][2], const Unit& u, int wr, int wc, int fr, int fq, PG8_LAS unsigned char* lds, int wid, int lane) const {
        PG8_LAS float* P = (PG8_LAS float*)lds;
        const int col0 = u.pn * BM + wc * 32 + 4 * fq;
#pragma unroll
        for (int ai = 0; ai < 2; ++ai)
#pragma unroll
            for (int m = 0; m < 4; ++m) { const int rt_ = ai * HALF + wr * 64 + m * 16 + fr; const size_t off = (size_t)(u.pm * BM + rt_) * 1024 + col0; float s = 0.f;
#pragma unroll
                for (int bj = 0; bj < 2; ++bj)
#pragma unroll
                    for (int n = 0; n < 2; ++n) { const f32x4 bs = *(const f32x4*)(h + off + bj * HALF + n * 16); const f32x4 o = bs + acc[ai][bj][m][n];
                        *(f32x4*)(h + off + bj * HALF + n * 16) = o; s += (o[0] * o[0] + o[1] * o[1]) + (o[2] * o[2] + o[3] * o[3]);
                        u32x2 w; w.x = cvt_pk_bf16(o[0], o[1]); w.y = cvt_pk_bf16(o[2], o[3]); *(u32x2*)(hb + off + 2048 + bj * HALF + n * 16) = w; }
                s += __shfl_xor(s, 16); s += __shfl_xor(s, 32);
                if (fq == 0) P[rt_ * 4 + wc] = s;
                if (m & 1) asm volatile("" ::: "memory"); }
        asm volatile("s_waitcnt lgkmcnt(0)" ::: "memory"); __builtin_amdgcn_s_barrier(); asm volatile("" ::: "memory");
        const int tid = wid * 64 + lane;
        if (tid < 256) { const float s = (P[tid * 4 + 0] + P[tid * 4 + 1]) + (P[tid * 4 + 2] + P[tid * 4 + 3]); ssq[(size_t)u.pn * MROWS + u.pm * BM + tid] = s; }
    }
};
template <int CTRL, bool BC> __device__ __forceinline__ float dppf(float old, float src) {
    return __builtin_bit_cast(float, __builtin_amdgcn_update_dpp(__builtin_bit_cast(int, old), __builtin_bit_cast(int, src), CTRL, 0xf, 0xf, BC)); }
struct EpiUpConv {
    static constexpr bool PERM = true, AFTER_DRAIN = false;
    bf16_t* act; const float* ssq; const float* cw; const float* cb;
    __device__ __forceinline__ void operator()(const f32x4 (&acc)[2][2][4][2], const Unit& u, int wr, int wc, int fr, int fq) const {
        const int b = u.pm / 17, j = u.pm % 17, T0 = b * 4096 + 248 * j;
        const int ch0 = 128 * u.pn + 32 * wc + 8 * fq;
        float rts[2][4];
#pragma unroll
        for (int ai = 0; ai < 2; ++ai)
#pragma unroll
            for (int m = 0; m < 4; ++m) { const int tok = T0 + 62 * (2 * ai + wr) + 16 * m + fr - 2; const int local = tok - b * 4096; const int tokc = tok < 0 ? 0 : (tok > MROWS - 1 ? MROWS - 1 : tok);
                rts[ai][m] = local < 0 ? 0.f : row_rstd(ssq, tokc); }
        u32x2 lo[2][4];
#pragma unroll
        for (int n = 0; n < 2; ++n) {
            f32x4 w[3][2], bb[2];
#pragma unroll
            for (int bj = 0; bj < 2; ++bj) { bb[bj] = *(const f32x4*)(cb + bj * 2816 + ch0 + 4 * n);
#pragma unroll
                for (int tp = 0; tp < 3; ++tp) w[tp][bj] = *(const f32x4*)(cw + tp * 5632 + bj * 2816 + ch0 + 4 * n); }
#pragma unroll
            for (int ai = 0; ai < 2; ++ai) { f32x4 pv[2];
#pragma unroll
                for (int m = 0; m < 4; ++m) { const int rho = 16 * m + fr, tok = T0 + 62 * (2 * ai + wr) + rho - 2, local = tok - b * 4096;
                    f32x4 uv[2], c[2];
#pragma unroll
                    for (int bj = 0; bj < 2; ++bj) { uv[bj] = acc[ai][bj][m][n] * rts[ai][m];
#pragma unroll
                        for (int e = 0; e < 4; ++e) { float s1 = dppf<0x111, true>(0.f, uv[bj][e]), s2 = dppf<0x112, true>(0.f, uv[bj][e]);
                            if (m > 0) { s1 = dppf<0x10F, false>(s1, pv[bj][e]); s2 = dppf<0x10E, false>(s2, pv[bj][e]); }
                            c[bj][e] = bb[bj][e] + w[0][bj][e] * s2 + w[1][bj][e] * s1 + w[2][bj][e] * uv[bj][e]; }
                        pv[bj] = uv[bj]; }
                    float o[4];
#pragma unroll
                    for (int e = 0; e < 4; ++e) { const float gt = c[1][e]; o[e] = gt * __builtin_amdgcn_rcpf(1.0f + __builtin_amdgcn_exp2f(-1.4426950408889634f * gt)) * c[0][e]; }
                    u32x2 pk; pk.x = cvt_pk_bf16(o[0], o[1]); pk.y = cvt_pk_bf16(o[2], o[3]);
                    if (n == 0) lo[ai][m] = pk;
                    else if (rho >= 2 && local < 4096) { u32x4 st; st.x = lo[ai][m].x; st.y = lo[ai][m].y; st.z = pk.x; st.w = pk.y; *(u32x4*)(act + (size_t)tok * 2816 + ch0) = st; }
                } }
        }
    }
};

template <class Epi, class Sched, bool ALIGN_EPI = false, bool SP2 = false>
__device__ __forceinline__ void gemm_phase(PG8_LAS unsigned char* lds, const Gemm g, const Sched& S, const Epi& E) {
    const int tid = opaque_tid(), wid = __builtin_amdgcn_readfirstlane(tid >> 6), lane = tid & 63, wr = wid >> 2, wc = wid & 3, fr = lane & 15, fq = lane >> 4;
    const int K = g.K, nt = K / BK;
    unsigned voffA[2], voffB[2];
#pragma unroll
    for (int i = 0; i < 2; ++i) { int R, C; stage_rc(tid * 16 + i * 8192, R, C); const int Rb = Epi::PERM ? ((R & ~31) + perm32(R & 31)) : R;
        voffA[i] = (unsigned)(g.arow(R) * K + C) * 2u; voffB[i] = (unsigned)(Rb * K + C) * 2u; }
    const size_t kstep = (size_t)(BK * 2);
    const size_t hstep = (size_t)HALF * K * 2; const size_t hstepA = (size_t)g.arow_half() * K * 2;
    const size_t tstep = 2 * hstep;
    const unsigned ldsw = (unsigned)wid * 1024u;
    const int aoff = lds_byte(wr * 64 + fr, fq * 8), boff = lds_byte(wc * 32 + fr, fq * 8);
#define PG8_SA(b, h) (((b) * 2 + (h)) * HTB)
#define PG8_SB(b, h) ((4 + (b) * 2 + (h)) * HTB)
#define PG8_STAGE(bufoff, gbase, voff) do { _Pragma("unroll") for (int _i = 0; _i < 2; ++_i) \
        __builtin_amdgcn_global_load_lds((const unsigned*)((const char*)(gbase) + (voff)[_i]), (PG8_LAS unsigned*)(lds + (bufoff) + ldsw + _i * 8192), 16, 0, 0); } while (0)
#define PG8_LDA(dst, b, h) do { _Pragma("unroll") for (int m = 0; m < 4; ++m) _Pragma("unroll") for (int k = 0; k < 2; ++k) dst[m][k] = *(const PG8_LAS bf16x8*)(lds + PG8_SA(b, h) + aoff + m * 2048 + k * 1024); } while (0)
#define PG8_LDB(dst, b, h) do { _Pragma("unroll") for (int n = 0; n < 2; ++n) _Pragma("unroll") for (int k = 0; k < 2; ++k) dst[n][k] = *(const PG8_LAS bf16x8*)(lds + PG8_SB(b, h) + boff + n * 2048 + k * 1024); } while (0)
#define PG8_MMA(ai, bj, At, Bt) do { __builtin_amdgcn_s_setprio(1); _Pragma("unroll") for (int m = 0; m < 4; ++m) _Pragma("unroll") for (int n = 0; n < 2; ++n) _Pragma("unroll") for (int k = 0; k < 2; ++k) \
        acc[ai][bj][m][n] = __builtin_amdgcn_mfma_f32_16x16x32_bf16(Bt[n][k], At[m][k], acc[ai][bj][m][n], 0, 0, 0); __builtin_amdgcn_s_setprio(0); } while (0)
#define PG8_WAIT_V(n) asm volatile("s_waitcnt vmcnt(" #n ")" ::: "memory")
#define PG8_WAIT_L(n) asm volatile("s_waitcnt lgkmcnt(" #n ")" ::: "memory")
#define PG8_BAR __builtin_amdgcn_s_barrier()
#define PG8_SCHED __builtin_amdgcn_sched_barrier(0)
    Unit cur, nxt; int ui = 0;
    if (!S.next(0, cur)) return;
    f32x4 acc[2][2][4][2];
#pragma unroll
    for (int a = 0; a < 2; ++a)
#pragma unroll
        for (int b = 0; b < 2; ++b)
#pragma unroll
            for (int m = 0; m < 4; ++m)
#pragma unroll
                for (int n = 0; n < 2; ++n) acc[a][b][m][n] = (f32x4){0.f, 0.f, 0.f, 0.f};
    bf16x8 At[4][2], B0[2][2], B1[2][2];
    const char* cA = (const char*)g.A + g.a_off(cur.pm); const char* cB = (const char*)g.Bt + (size_t)cur.pn * tstep;
    S.a_ready(cur);
    if constexpr (SP2) {
        PG8_STAGE(PG8_SB(0, 0), cB, voffB); PG8_STAGE(PG8_SB(0, 1), cB + hstep, voffB); PG8_STAGE(PG8_SA(0, 0), cA, voffA); PG8_STAGE(PG8_SA(0, 1), cA + hstepA, voffA);
        if (wr == 1) PG8_BAR;
        PG8_WAIT_V(2); PG8_BAR;
        PG8_STAGE(PG8_SB(1, 0), cB + kstep, voffB); PG8_STAGE(PG8_SA(1, 0), cA + kstep, voffA); PG8_STAGE(PG8_SB(1, 1), cB + hstep + kstep, voffB);
        PG8_WAIT_V(6); PG8_BAR;
    } else {
        PG8_STAGE(PG8_SB(0, 0), cB, voffB); PG8_STAGE(PG8_SA(0, 0), cA, voffA); PG8_STAGE(PG8_SB(0, 1), cB + hstep, voffB); PG8_STAGE(PG8_SA(0, 1), cA + hstepA, voffA);
        if (wr == 1) PG8_BAR;
        PG8_WAIT_V(4); PG8_BAR;
        PG8_STAGE(PG8_SB(1, 0), cB + kstep, voffB); PG8_STAGE(PG8_SA(1, 0), cA + kstep, voffA); PG8_STAGE(PG8_SB(1, 1), cB + hstep + kstep, voffB);
        PG8_WAIT_V(6); PG8_BAR;
    }
    for (;;) {
        const bool has_next = S.next(ui + 1, nxt);
        const char* nA = has_next ? (const char*)g.A + g.a_off(nxt.pm) : cA; const char* nB = has_next ? (const char*)g.Bt + (size_t)nxt.pn * tstep : cB;
        for (int t = 0; t < nt; t += 2) {
            const bool last = (t == nt - 2);
            const char* a1 = cA + (size_t)(t + 1) * kstep;
            const char* a2 = last ? nA : cA + (size_t)(t + 2) * kstep; const char* b2 = last ? nB : cB + (size_t)(t + 2) * kstep;
            const char* a3 = a2 + kstep; const char* b3 = b2 + kstep;
            if (last && has_next) S.a_ready(nxt);
            if constexpr (SP2) {
            PG8_LDB(B0, 0, 0); PG8_LDB(B1, 0, 1); PG8_SCHED; PG8_LDA(At, 0, 0); PG8_STAGE(PG8_SA(1, 1), a1 + hstepA, voffA);
            PG8_WAIT_V(8); PG8_WAIT_L(0); PG8_BAR; PG8_MMA(0, 0, At, B0); PG8_MMA(0, 1, At, B1); PG8_BAR; PG8_SCHED;
            PG8_LDA(At, 0, 1); PG8_STAGE(PG8_SB(0, 0), b2, voffB); PG8_STAGE(PG8_SB(0, 1), b2 + hstep, voffB); PG8_STAGE(PG8_SA(0, 0), a2, voffA);
            PG8_WAIT_V(8); PG8_WAIT_L(0); PG8_BAR; PG8_MMA(1, 0, At, B0); PG8_MMA(1, 1, At, B1); PG8_BAR; PG8_SCHED;
            PG8_LDB(B0, 1, 0); PG8_LDB(B1, 1, 1); PG8_SCHED; PG8_LDA(At, 1, 0); PG8_STAGE(PG8_SA(0, 1), a2 + hstepA, voffA);
            PG8_WAIT_V(8); PG8_WAIT_L(0); PG8_BAR; PG8_MMA(0, 0, At, B0); PG8_MMA(0, 1, At, B1); PG8_BAR; PG8_SCHED;
            PG8_LDA(At, 1, 1); PG8_STAGE(PG8_SB(1, 0), b3, voffB); PG8_STAGE(PG8_SB(1, 1), b3 + hstep, voffB); PG8_STAGE(PG8_SA(1, 0), a3, voffA);
            PG8_WAIT_V(8); PG8_WAIT_L(0); PG8_BAR; PG8_MMA(1, 0, At, B0); PG8_MMA(1, 1, At, B1); PG8_BAR; PG8_SCHED;
            } else {
            PG8_LDB(B0, 0, 0); PG8_SCHED; PG8_LDA(At, 0, 0); PG8_STAGE(PG8_SA(1, 1), a1 + hstepA, voffA);
            PG8_WAIT_L(8); PG8_BAR; PG8_WAIT_L(0); PG8_MMA(0, 0, At, B0); PG8_BAR; PG8_SCHED;
            PG8_LDB(B1, 0, 1); PG8_STAGE(PG8_SB(0, 0), b2, voffB);
            PG8_BAR; PG8_WAIT_L(0); PG8_MMA(0, 1, At, B1); PG8_BAR;
            PG8_LDA(At, 0, 1); PG8_STAGE(PG8_SA(0, 0), a2, voffA);
            PG8_BAR; PG8_WAIT_L(0); PG8_MMA(1, 0, At, B0); PG8_BAR; PG8_SCHED;
            PG8_STAGE(PG8_SB(0, 1), b2 + hstep, voffB);
            PG8_WAIT_V(6); PG8_BAR; PG8_MMA(1, 1, At, B1); PG8_BAR;
            PG8_LDB(B0, 1, 0); PG8_SCHED; PG8_LDA(At, 1, 0); PG8_STAGE(PG8_SA(0, 1), a2 + hstepA, voffA);
            PG8_WAIT_L(8); PG8_BAR; PG8_WAIT_L(0); PG8_MMA(0, 0, At, B0); PG8_BAR; PG8_SCHED;
            PG8_LDB(B1, 1, 1); PG8_STAGE(PG8_SB(1, 0), b3, voffB);
            PG8_BAR; PG8_WAIT_L(0); PG8_MMA(0, 1, At, B1); PG8_BAR;
            PG8_LDA(At, 1, 1); PG8_STAGE(PG8_SA(1, 0), a3, voffA);
            PG8_BAR; PG8_WAIT_L(0); PG8_MMA(1, 0, At, B0); PG8_BAR; PG8_SCHED;
            PG8_STAGE(PG8_SB(1, 1), b3 + hstep, voffB);
            PG8_WAIT_V(6); PG8_BAR; PG8_MMA(1, 1, At, B1); PG8_BAR;
            }
        }
        if constexpr (ALIGN_EPI) { if (wr == 0) PG8_BAR; }
        if constexpr (!Epi::AFTER_DRAIN) { E(acc, cur, wr, wc, fr, fq); S.done(cur); }
        if (!has_next) break;
#pragma unroll
        for (int a = 0; a < 2; ++a)
#pragma unroll
            for (int b = 0; b < 2; ++b)
#pragma unroll
                for (int m = 0; m < 4; ++m)
#pragma unroll
                    for (int n = 0; n < 2; ++n) acc[a][b][m][n] = (f32x4){0.f, 0.f, 0.f, 0.f};
        cur = nxt; cA = nA; cB = nB; ++ui;
        if constexpr (ALIGN_EPI) { if (wr == 1) PG8_BAR; }
    }
    PG8_WAIT_V(0);
    if constexpr (!ALIGN_EPI) { if (wr == 0) PG8_BAR; }
    PG8_BAR;
    if constexpr (Epi::AFTER_DRAIN) { E.fused(acc, cur, wr, wc, fr, fq, lds, wid, lane); S.done(cur); }
#undef PG8_SA
#undef PG8_SB
#undef PG8_STAGE
#undef PG8_LDA
#undef PG8_LDB
#undef PG8_MMA
#undef PG8_WAIT_V
#undef PG8_WAIT_L
#undef PG8_BAR
#undef PG8_SCHED
}
}

#define PG8_SP2 true
#define PG8_ALIGN true
namespace attn_body {
using bf16=__hip_bfloat16;
using bf16x8=__attribute__((ext_vector_type(8)))short;
using s16x4=__attribute__((ext_vector_type(4)))short;
using f32x16=__attribute__((ext_vector_type(16)))float;
using u32x4=__attribute__((ext_vector_type(4)))unsigned;
typedef float f32x4a __attribute__((ext_vector_type(4)));
constexpr int D=64;
constexpr int NW=8,QBLK=32,QB=QBLK*NW,KVBLK=64;
__device__ __forceinline__ int crow(int r,int hi){return (r&3)+8*(r>>2)+4*hi;}
#define SBAR() __builtin_amdgcn_sched_barrier(0)
constexpr int NSLOT=3, SLOTB=8192;
constexpr int LDS_K=0, LDS_V=NSLOT*SLOTB, LDS_WS=2*NSLOT*SLOTB, LDS_OST=LDS_WS+NW*64*4, LDS_BYTES=LDS_OST+NW*4096;
constexpr float C2=0.125f*1.4426950408889634f;
__device__ __forceinline__ void glds16(const void*gsrc,unsigned lds_dst){unsigned keep;
  asm volatile("s_mov_b32 %0, m0\n\ts_mov_b32 m0, %2\n\ts_nop 0\n\tglobal_load_lds_dwordx4 %1, off\n\ts_mov_b32 m0, %0":"=&s"(keep):"v"(gsrc),"s"(lds_dst):"memory");}
__device__ __forceinline__ float max3f(float a,float b,float c){float r;asm("v_max3_f32 %0, %1, %2, %3":"=v"(r):"v"(a),"v"(b),"v"(c));return r;}
__device__ __forceinline__ float max2f(float a,float b){float r;asm("v_max_f32_e32 %0, %1, %2":"=v"(r):"v"(a),"v"(b));return r;}
__device__ __forceinline__ float fadd_s(float a,float b){float r;asm("v_add_f32_e32 %0, %1, %2":"=v"(r):"v"(a),"v"(b));return r;}
__device__ __forceinline__ float fsub_s(float a,float b){float r;asm("v_sub_f32_e32 %0, %1, %2":"=v"(r):"v"(a),"v"(b));return r;}
typedef float f32x2_t __attribute__((ext_vector_type(2))); typedef __bf16 bf16x2_t __attribute__((ext_vector_type(2)));
__device__ __forceinline__ unsigned cvtpk_s(float lo,float hi){f32x2_t v={lo,hi};bf16x2_t b=__builtin_convertvector(v,bf16x2_t);return __builtin_bit_cast(unsigned,b);}
#define WAIT_BAR(N) asm volatile("s_waitcnt vmcnt(" #N ") lgkmcnt(0)\n\ts_barrier":::"memory")

__device__ __forceinline__ void qkt(f32x16&p0,f32x16&p1,const char*Kslot,const bf16x8*qr,const f32x16&negm,int r32,int hi){
  const char*kb=Kslot+hi*1024+r32*16;
  #pragma unroll
  for(int d0=0;d0<4;++d0){
    const bf16x8 b0=*reinterpret_cast<const bf16x8*>(kb+d0*2048);
    const bf16x8 b1=*reinterpret_cast<const bf16x8*>(kb+d0*2048+512);
    if(d0==0){p0=__builtin_amdgcn_mfma_f32_32x32x16_bf16(b0,qr[0],negm,0,0,0);p1=__builtin_amdgcn_mfma_f32_32x32x16_bf16(b1,qr[0],negm,0,0,0);}
    else{p0=__builtin_amdgcn_mfma_f32_32x32x16_bf16(b0,qr[d0],p0,0,0,0);p1=__builtin_amdgcn_mfma_f32_32x32x16_bf16(b1,qr[d0],p1,0,0,0);}}
}
typedef __attribute__((address_space(3))) const char* lds_cptr;
typedef short v4i16_t __attribute__((ext_vector_type(4)));
__device__ __forceinline__ void kload8(bf16x8*kf,lds_cptr kp){
  kf[0]=*(const __attribute__((address_space(3))) bf16x8*)(kp);      kf[1]=*(const __attribute__((address_space(3))) bf16x8*)(kp+512);
  kf[2]=*(const __attribute__((address_space(3))) bf16x8*)(kp+2048); kf[3]=*(const __attribute__((address_space(3))) bf16x8*)(kp+2560);
  kf[4]=*(const __attribute__((address_space(3))) bf16x8*)(kp+4096); kf[5]=*(const __attribute__((address_space(3))) bf16x8*)(kp+4608);
  kf[6]=*(const __attribute__((address_space(3))) bf16x8*)(kp+6144); kf[7]=*(const __attribute__((address_space(3))) bf16x8*)(kp+6656);
}
__device__ __forceinline__ void kload2(bf16x8*kf,lds_cptr kp,int j){ kf[2*j]=*(const __attribute__((address_space(3))) bf16x8*)(kp+j*2048); kf[2*j+1]=*(const __attribute__((address_space(3))) bf16x8*)(kp+j*2048+512); }
__device__ __forceinline__ s16x4 vtr(lds_cptr p){ return __builtin_bit_cast(s16x4,__builtin_amdgcn_ds_read_tr16_b64_v4i16((__attribute__((address_space(3))) v4i16_t*)p)); }
__device__ __forceinline__ float rowmax(const f32x16&p0,const f32x16&p1){
  float a=max3f(p0[0],p0[1],p1[0]),b=max3f(p0[2],p0[3],p1[1]);a=max3f(a,p1[2],p1[3]);
  #pragma unroll
  for(int r=4;r<16;r+=4){a=max3f(a,p0[r],p0[r+1]);b=max3f(b,p0[r+2],p0[r+3]);a=max3f(a,p1[r],p1[r+1]);b=max3f(b,p1[r+2],p1[r+3]);}
  const float m=max2f(a,b);
  auto rr=__builtin_amdgcn_permlane32_swap(__float_as_uint(m),__float_as_uint(m),false,false);
  return max2f(__uint_as_float(rr[0]),__uint_as_float(rr[1]));
}
__device__ __forceinline__ void pv(f32x16*o,int vb,bf16x8 pa0,bf16x8 pa1,bf16x8 pa2,bf16x8 pa3){
  #pragma unroll
  for(int d0=0;d0<2;++d0){s16x4 lo[4],hi[4];
    #pragma unroll
    for(int ks=0;ks<4;++ks){
      asm volatile("ds_read_b64_tr_b16 %0,%1 offset:%c2":"=&v"(lo[ks]):"v"(vb),"i"(d0*4096+ks*1024):"memory");
      asm volatile("ds_read_b64_tr_b16 %0,%1 offset:%c2":"=&v"(hi[ks]):"v"(vb),"i"(d0*4096+ks*1024+512):"memory");}
    asm volatile("s_waitcnt lgkmcnt(0)":::"memory");SBAR();
    #define PK(k) (bf16x8){lo[k][0],lo[k][1],lo[k][2],lo[k][3],hi[k][0],hi[k][1],hi[k][2],hi[k][3]}
    o[d0]=__builtin_amdgcn_mfma_f32_32x32x16_bf16(pa0,PK(0),o[d0],0,0,0);
    o[d0]=__builtin_amdgcn_mfma_f32_32x32x16_bf16(pa1,PK(1),o[d0],0,0,0);
    o[d0]=__builtin_amdgcn_mfma_f32_32x32x16_bf16(pa2,PK(2),o[d0],0,0,0);
    o[d0]=__builtin_amdgcn_mfma_f32_32x32x16_bf16(pa3,PK(3),o[d0],0,0,0);
    #undef PK
  }
}
constexpr int LDS_CS=86016;
static_assert(LDS_BYTES<=LDS_CS,"attention LDS map");
struct AttnDesc {
  const bf16*Q; bf16*O; const bf16*K; const bf16*V; float*lse; const unsigned char*ws;
  int qstride,ostride,kstride,lstride;
  int q0,t_lo,NT,W,qadd,fox,mode;
  int mrg_off,lse_off;
};
__device__ __forceinline__ void bmask(f32x16&p0,f32x16&p1,int dq,int Wb){
  const float NEG=-INFINITY;
  #pragma unroll
  for(int r=0;r<16;++r){const int e0=dq-((r&3)+8*(r>>2)); if((unsigned)e0>(unsigned)Wb)p0[r]=NEG; if((unsigned)(e0-32)>(unsigned)Wb)p1[r]=NEG;}
}
__device__ __forceinline__ void kbias(f32x16&p0,f32x16&p1,lds_cptr cp){
  #pragma unroll
  for(int g=0;g<4;++g){
    const f32x4a a=*(const __attribute__((address_space(3))) f32x4a*)(cp+32*g), b=*(const __attribute__((address_space(3))) f32x4a*)(cp+128+32*g);
    #pragma unroll
    for(int e=0;e<4;++e){p0[4*g+e]-=a[e];p1[4*g+e]-=b[e];}}
}
#ifndef ATTN_STORE16
#define ATTN_STORE16(p,v) (*(u32x4*)(p)=(v))
#endif
template<int THRL> __device__ __forceinline__ void attn_unit(const AttnDesc&U,char*shm){
  const int tid=opaque_tid(),lane=tid&63,r32=lane&31,hi=lane>>5; const int wid=__builtin_amdgcn_readfirstlane(tid>>6);
  const int q0=U.q0; const long ktile=(long)KVBLK*U.kstride;
  const bf16*Qw=U.Q+(long)(q0+wid*QBLK)*U.qstride;
  const bf16*Kh=U.K+(long)U.t_lo*ktile,*Vh=U.V+(long)U.t_lo*ktile;
  const unsigned lds0=(unsigned)(uintptr_t)shm;
  float*wsf=(float*)(shm+LDS_WS)+wid*64;
  const bf16*ksrc=Kh+(long)lane*U.kstride+wid*8;
  const bf16*vsrc=Vh+(long)(16*(wid&3)+(lane>>2))*U.kstride+(wid>>2)*32+(lane&3)*8;
  const unsigned kdst=lds0+LDS_K+wid*1024, vdst=lds0+LDS_V+wid*1024;
  #define DMA_K(t,slot) glds16(ksrc+(long)(t)*ktile,(unsigned)__builtin_amdgcn_readfirstlane(kdst+(slot)))
  #define DMA_V(t,slot) glds16(vsrc+(long)(t)*ktile,(unsigned)__builtin_amdgcn_readfirstlane(vdst+(slot)))
  const int vb0=(int)(lds0+LDS_V)+((lane>>4)&1)*32+(lane&3)*8+(4*hi+((lane&15)>>2))*64;
  const char*Kbase=shm+LDS_K; bf16x8 kf[8];
  const lds_cptr shm3=(lds_cptr)shm; const lds_cptr kp0=shm3+LDS_K+hi*1024+r32*16; const lds_cptr vp0=shm3+LDS_V+((lane>>4)&1)*32+(lane&3)*8+(4*hi+((lane&15)>>2))*64;
  const int NT=U.NT;
  DMA_K(0,0);DMA_V(0,0);DMA_K(1,SLOTB);
  bf16x8 qr[4];
  #pragma unroll
  for(int d0=0;d0<4;++d0)qr[d0]=*reinterpret_cast<const bf16x8*>(&Qw[(long)r32*U.qstride+d0*16+hi*8]);
  float mhat=0.f,l_reg=0.f;f32x16 o[2];f32x16 negm; { float zf=0.f; asm volatile("":"+v"(zf)); _Pragma("unroll") for(int r=0;r<16;++r){o[0][r]=zf;o[1][r]=zf;negm[r]=zf;} } asm volatile("":"+v"(negm));
  const int qi=q0+wid*QBLK+r32+U.qadd, qlo=q0+wid*QBLK+U.qadd, Wb=U.W, foxf=U.fox; const lds_cptr csp=(lds_cptr)shm+LDS_CS;
  #define CMASK(P0,P1,t) do{ const int kl_=64*(U.t_lo+(t)); if(foxf)kbias(P0,P1,csp+4*(kl_+4*hi)); if(!((qlo-(kl_+63)>=0)&&(qlo+31-kl_<=Wb)))bmask(P0,P1,qi-kl_-4*hi,Wb); }while(0)
  bool resc=false;
  #define START(P0,P1) do{ const float rm=rowmax(P0,P1); resc=false; \
    { const float dl=(rm>-1e37f)?rm:0.f; mhat=fadd_s(mhat,dl); \
      _Pragma("unroll") for(int r=0;r<16;++r){P0[r]=fsub_s(P0[r],dl);P1[r]=fsub_s(P1[r],dl);} \
      _Pragma("unroll") for(int r=0;r<16;++r)negm[r]=-mhat; asm volatile("":"+v"(negm)); } \
    _Pragma("unroll") for(int r=0;r<16;++r)P0[r]=__builtin_amdgcn_exp2f(P0[r]); }while(0)
  #define RESC() do{ if(resc){ asm volatile("s_waitcnt lgkmcnt(0)":::"memory"); \
      _Pragma("unroll") for(int d_=0;d_<2;++d_) _Pragma("unroll") for(int r=0;r<16;++r)o[d_][r]*=wsf[crow(r,hi)]; } }while(0)
  f32x16 pA0,pA1,pB0,pB1;
  int sl_prev=0,sl_cur=0,sl_next=SLOTB;
  #define ROT() do{sl_prev=sl_cur;sl_cur=sl_next;sl_next=(sl_next==(NSLOT-1)*SLOTB)?0:sl_next+SLOTB;}while(0)
  DMA_K(2,2*SLOTB);
  WAIT_BAR(3);
  qkt(pA0,pA1,Kbase,qr,negm,r32,hi);asm volatile("s_nop 15\n\ts_nop 7":"+v"(pA0),"+v"(pA1));CMASK(pA0,pA1,0);
  START(pA0,pA1);
  _Pragma("unroll") for(int r=0;r<16;++r)pA1[r]=__builtin_amdgcn_exp2f(pA1[r]);
  WAIT_BAR(0);
  DMA_K(3,0);DMA_V(1,SLOTB);
  ROT();
  kload8(kf,kp0+sl_cur);
  WAIT_BAR(2);
  s16x4 vlo[8],vhi[8]; u32x4 pw0,pw1,pw2,pw3;
  #define PKW(P,B) cvtpk_s(P[B],P[B+1])
  #define PAF(k) __builtin_bit_cast(bf16x8,pw##k)
  #define VFR(i) (bf16x8){vlo[i][0],vlo[i][1],vlo[i][2],vlo[i][3],vhi[i][0],vhi[i][1],vhi[i][2],vhi[i][3]}
  #define PIN(x) asm volatile("":"+v"(x))
  #define MX3(a,b,c) __builtin_fmaxf(__builtin_fmaxf((a),(b)),(c))
  #define GAPA(MF,A0,A1,A2,A3,W0,W1,PW) do{ MF; sacc+=A0; sacc+=A1; sacc+=A2; sacc+=A3; PIN(sacc); W0; W1; PIN(PW); SBAR(); }while(0)
  #define EX(v) __builtin_amdgcn_exp2f(v)
  #define GAPB(MF,X,B) do{ MF; X[B]=EX(X[B]); X[B+1]=EX(X[B+1]); X[B+2]=EX(X[B+2]); X[B+3]=EX(X[B+3]); PIN(X); SBAR(); }while(0)
  #define VRD(i) do{ vlo[i]=vtr(vp_+(((i)>>2)*4096+((i)&3)*1024)); vhi[i]=vtr(vp_+(((i)>>2)*4096+((i)&3)*1024+512)); }while(0)
  #define KRD(G,j) do{ if(G){ kload2(kf,kp0+sl_next,j); SBAR(); } }while(0)
  #define STEP(C0,C1,P0,P1,t,GK,GV,GL) do{ SBAR(); \
    const lds_cptr vp_=vp0+sl_prev; \
    VRD(0); SBAR(); float sacc=(P0[0]+P0[1]); \
    GAPA(C0=__builtin_amdgcn_mfma_f32_32x32x16_bf16(kf[0],qr[0],negm,0,0,0), P0[2],P0[3],P0[4],P0[5],     pw0[0]=PKW(P0,0), pw0[1]=PKW(P0,2), pw0); \
    VRD(4); SBAR(); GAPA(C1=__builtin_amdgcn_mfma_f32_32x32x16_bf16(kf[1],qr[0],negm,0,0,0), P0[6],P0[7],P0[8],P0[9],     pw0[2]=PKW(P0,4), pw0[3]=PKW(P0,6), pw0); \
    VRD(1); SBAR(); GAPA(C0=__builtin_amdgcn_mfma_f32_32x32x16_bf16(kf[2],qr[1],C0,0,0,0),   P0[10],P0[11],P0[12],P0[13], pw1[0]=PKW(P0,8), pw1[1]=PKW(P0,10), pw1); \
    VRD(5); SBAR(); GAPA(C1=__builtin_amdgcn_mfma_f32_32x32x16_bf16(kf[3],qr[1],C1,0,0,0),   P0[14],P0[15],P1[0],P1[1],   pw1[2]=PKW(P0,12),pw1[3]=PKW(P0,14), pw1); \
    VRD(2); SBAR(); GAPA(C0=__builtin_amdgcn_mfma_f32_32x32x16_bf16(kf[4],qr[2],C0,0,0,0),   P1[2],P1[3],P1[4],P1[5],     pw2[0]=PKW(P1,0), pw2[1]=PKW(P1,2), pw2); \
    VRD(6); SBAR(); GAPA(C1=__builtin_amdgcn_mfma_f32_32x32x16_bf16(kf[5],qr[2],C1,0,0,0),   P1[6],P1[7],P1[8],P1[9],     pw2[2]=PKW(P1,4), pw2[3]=PKW(P1,6), pw2); \
    VRD(3); SBAR(); GAPA(C0=__builtin_amdgcn_mfma_f32_32x32x16_bf16(kf[6],qr[3],C0,0,0,0),   P1[10],P1[11],P1[12],P1[13], pw3[0]=PKW(P1,8), pw3[1]=PKW(P1,10), pw3); \
    VRD(7); SBAR(); GAPA(C1=__builtin_amdgcn_mfma_f32_32x32x16_bf16(kf[7],qr[3],C1,0,0,0),   P1[14],P1[15],0.f,0.f,       pw3[2]=PKW(P1,12),pw3[3]=PKW(P1,14), pw3); \
    l_reg+=sacc; \
    if(GK){DMA_K((t)+3,sl_cur);} if(GV){DMA_V((t)+1,sl_next);} \
    CMASK(C0,C1,t); \
    { float a=MX3(C0[0],C0[1],C1[0]),b=MX3(C0[2],C0[3],C1[1]); a=MX3(a,C1[2],C1[3]); \
      _Pragma("unroll") for(int r=4;r<16;r+=4){a=MX3(a,C0[r],C0[r+1]);b=MX3(b,C0[r+2],C0[r+3]);a=MX3(a,C1[r],C1[r+1]);b=MX3(b,C1[r+2],C1[r+3]);} \
      float rm=__builtin_fmaxf(a,b); { auto rr=__builtin_amdgcn_permlane32_swap(__float_as_uint(rm),__float_as_uint(rm),false,false); rm=__builtin_fmaxf(__uint_as_float(rr[0]),__uint_as_float(rr[1])); } \
      resc=false; \
      if(__builtin_expect(__any(rm>(float)THRL),0)){ const float dl=__builtin_fmaxf(rm,0.f); mhat+=dl; \
        _Pragma("unroll") for(int r=0;r<16;++r){C0[r]-=dl;C1[r]-=dl;} \
        _Pragma("unroll") for(int r=0;r<16;++r)negm[r]=-mhat; asm volatile("":"+v"(negm)); \
        const float f=__builtin_amdgcn_exp2f(-dl); l_reg*=f; if(hi==0)wsf[r32]=f; resc=true; } } \
    SBAR(); \
    GAPB(o[0]=__builtin_amdgcn_mfma_f32_32x32x16_bf16(PAF(0),VFR(0),o[0],0,0,0), C0,0); \
    GAPB(o[1]=__builtin_amdgcn_mfma_f32_32x32x16_bf16(PAF(0),VFR(4),o[1],0,0,0), C0,4); \
    KRD(GL,0); GAPB(o[0]=__builtin_amdgcn_mfma_f32_32x32x16_bf16(PAF(1),VFR(1),o[0],0,0,0), C0,8); \
    KRD(GL,1); GAPB(o[1]=__builtin_amdgcn_mfma_f32_32x32x16_bf16(PAF(1),VFR(5),o[1],0,0,0), C0,12); \
    KRD(GL,2); GAPB(o[0]=__builtin_amdgcn_mfma_f32_32x32x16_bf16(PAF(2),VFR(2),o[0],0,0,0), C1,0); \
    KRD(GL,3); GAPB(o[1]=__builtin_amdgcn_mfma_f32_32x32x16_bf16(PAF(2),VFR(6),o[1],0,0,0), C1,4); \
    GAPB(o[0]=__builtin_amdgcn_mfma_f32_32x32x16_bf16(PAF(3),VFR(3),o[0],0,0,0), C1,8); \
    GAPB(o[1]=__builtin_amdgcn_mfma_f32_32x32x16_bf16(PAF(3),VFR(7),o[1],0,0,0), C1,12); \
    }while(0)
  int t=1;
  for(;t+5<NT;t+=2){
    STEP(pB0,pB1,pA0,pA1,t,true,true,true);     WAIT_BAR(2); RESC(); ROT();
    STEP(pA0,pA1,pB0,pB1,t+1,true,true,true);   WAIT_BAR(2); RESC(); ROT();
  }
  #define ENDW(tt) do{ if((tt)+3<NT){WAIT_BAR(2);} else if((tt)+2<NT){WAIT_BAR(1);} else {WAIT_BAR(0);} }while(0)
  for(;t+1<NT;t+=2){
    STEP(pB0,pB1,pA0,pA1,t,(t+3<NT),(t+1<NT),(t+1<NT));       ENDW(t);   RESC(); ROT();
    STEP(pA0,pA1,pB0,pB1,t+1,(t+4<NT),(t+2<NT),(t+2<NT));     ENDW(t+1); RESC(); ROT();
  }
  STEP(pB0,pB1,pA0,pA1,NT-1,false,false,false); RESC();
  { float sacc=pB0[0]+pB0[1]; _Pragma("unroll") for(int r=2;r<16;++r)sacc+=pB0[r]; _Pragma("unroll") for(int r=0;r<16;++r)sacc+=pB1[r]; l_reg+=sacc;
    pw0=(u32x4){PKW(pB0,0),PKW(pB0,2),PKW(pB0,4),PKW(pB0,6)};pw1=(u32x4){PKW(pB0,8),PKW(pB0,10),PKW(pB0,12),PKW(pB0,14)};pw2=(u32x4){PKW(pB1,0),PKW(pB1,2),PKW(pB1,4),PKW(pB1,6)};pw3=(u32x4){PKW(pB1,8),PKW(pB1,10),PKW(pB1,12),PKW(pB1,14)};
    SBAR(); pv(o,vb0+sl_cur,PAF(0),PAF(1),PAF(2),PAF(3)); }
  #undef PKW
  #undef PAF
  #undef VFR
  #undef PIN
  #undef MX3
  #undef GAPA
  #undef GAPB
  #undef EX
  #undef VRD
  #undef KRD
  #undef STEP
  #undef ENDW
  {auto rr=__builtin_amdgcn_permlane32_swap(__float_as_uint(l_reg),__float_as_uint(l_reg),false,false);l_reg=__uint_as_float(rr[0])+__uint_as_float(rr[1]);}
  const float lse_own=mhat+__log2f(l_reg);
  if(hi==0){wsf[32+r32]=l_reg;wsf[r32]=lse_own;}
  asm volatile("s_waitcnt lgkmcnt(0)":::"memory");
  if(U.mode==1&&hi==0)U.lse[(long)(q0+wid*QBLK+r32)*U.lstride]=lse_own;
  float rli[16];
  #pragma unroll
  for(int r=0;r<16;++r)rli[r]=__builtin_amdgcn_rcpf(wsf[32+crow(r,hi)]);
  bf16*Ow=U.O+(long)(q0+wid*QBLK)*U.ostride;
  { bf16*stg=(bf16*)(shm+LDS_OST)+wid*2048;
    #pragma unroll
    for(int r=0;r<16;++r){const int orow=crow(r,hi);
      #pragma unroll
      for(int d0=0;d0<2;++d0)stg[orow*64+d0*32+r32]=__float2bfloat16(o[d0][r]*rli[r]);}
    asm volatile("s_waitcnt lgkmcnt(0)":::"memory");
    #pragma unroll
    for(int i=0;i<4;++i){const int row=i*8+(lane>>3),ch=lane&7; u32x4 v=*(const u32x4*)(stg+row*64+ch*8);
      if(U.mode==2){ const int pos=q0+wid*QBLK+row; const float l1=wsf[row],l4=((const float*)(U.ws+WS_LSE4))[U.lse_off+pos],l16=((const float*)(U.ws+WS_LSE16))[U.lse_off+pos];
        const float mx=fmaxf(l1,fmaxf(l4,l16)); float w1=__builtin_amdgcn_exp2f(l1-mx),w4=__builtin_amdgcn_exp2f(l4-mx),w16=__builtin_amdgcn_exp2f(l16-mx);
        const float inv=1.0f/(w1+w4+w16); w1*=inv; w4*=inv; w16*=inv;
        const u32x4 a4=*(const u32x4*)((const bf16*)(U.ws+WS_OB4)+U.mrg_off+(long)pos*768+ch*8), a16=*(const u32x4*)((const bf16*)(U.ws+WS_OB16)+U.mrg_off+(long)pos*768+ch*8);
        #pragma unroll
        for(int e=0;e<4;++e){
          const float lo=w1*__uint_as_float(v[e]<<16)+w4*__uint_as_float(a4[e]<<16)+w16*__uint_as_float(a16[e]<<16);
          const float hh=w1*__uint_as_float(v[e]&0xffff0000u)+w4*__uint_as_float(a4[e]&0xffff0000u)+w16*__uint_as_float(a16[e]&0xffff0000u);
          v[e]=cvtpk_s(lo,hh);} }
      ATTN_STORE16(Ow+(long)row*U.ostride+ch*8,v);} }
  asm volatile("s_waitcnt lgkmcnt(0)\n\ts_barrier":::"memory");
  #undef DMA_K
  #undef DMA_V
  #undef CMASK
  #undef START
  #undef RESC
  #undef ROT
}
__device__ __forceinline__ void fox_scan(const float*fl,char*shm){
  const int tid=opaque_tid(),lane=tid&63,wid=tid>>6;
  const f32x4a a=((const f32x4a*)fl)[2*tid],b=((const f32x4a*)fl)[2*tid+1];
  float v[8]={a[0],a[1],a[2],a[3],b[0],b[1],b[2],b[3]};
  #pragma unroll
  for(int i=1;i<8;++i)v[i]+=v[i-1];
  float incl=v[7];
  #pragma unroll
  for(int o=1;o<64;o<<=1){const float t=__shfl_up(incl,o);if(lane>=o)incl+=t;}
  const float excl=incl-v[7];
  float*wt=(float*)(shm+LDS_CS+16384);
  if(lane==63)wt[wid]=incl;
  __syncthreads();
  float base=excl;
  for(int w=0;w<wid;++w)base+=wt[w];
  const float L2E=1.4426950408889634f;
  f32x4a o0,o1;
  #pragma unroll
  for(int i=0;i<4;++i){o0[i]=(base+v[i])*L2E;o1[i]=(base+v[4+i])*L2E;}
  f32x4a*cs=(f32x4a*)(shm+LDS_CS);
  cs[2*tid]=o0;cs[2*tid+1]=o1;
  __syncthreads();
}
#undef SBAR
#undef WAIT_BAR
}

constexpr int LDSCTL_OFF = 0, LDSCTL_BYTES = 2048, MISC_OFF = LDSCTL_OFF + 320;
constexpr int RING_OFF = LDSCTL_BYTES, RING_BYTES = 131072;
constexpr int LDS_BYTES = 147456;
static_assert(attn_body::LDS_CS + 16384 + 64 <= RING_BYTES && RING_OFF + RING_BYTES <= LDS_BYTES, "LDS map");

#define GAS __attribute__((address_space(1)))
#define LAS __attribute__((address_space(3)))
typedef unsigned short bf16;
typedef unsigned v4u __attribute__((ext_vector_type(4)));
typedef float f32x4 __attribute__((ext_vector_type(4)));
typedef short bf16x8 __attribute__((ext_vector_type(8)));
typedef GAS unsigned gu32;
typedef GAS unsigned long long gu64;
#define RLX_AGENT __ATOMIC_RELAXED, __HIP_MEMORY_SCOPE_AGENT
#define LDS_WAIT() asm volatile("s_waitcnt lgkmcnt(0)" ::: "memory")
#define VM_WAIT() asm volatile("s_waitcnt vmcnt(0)" ::: "memory")
__device__ __forceinline__ unsigned long long rt() { return __builtin_amdgcn_s_memrealtime(); }
__device__ __forceinline__ unsigned f2bf(float f) { unsigned u = __builtin_bit_cast(unsigned, f); return (u + 0x7fffu + ((u >> 16) & 1u)) >> 16; }
__device__ __forceinline__ unsigned pk2(float lo, float hi) { return f2bf(lo) | (f2bf(hi) << 16); }

#define XB_TMO      128
#define XB_XCNT(j)  (256  + 64 * (j))
#define XB_XSUB(j)  (1280 + 64 * (j))
#define XB_XGEN(j)  (2304 + 64 * (j))
#define XB_TOP      3328
#define XB_TOPGEN   3392
#define XCD_BAR_WORDS 3456
#define XB_SPIN_CAP (1u << 18)

__device__ __forceinline__ unsigned xb_ld(unsigned* p)              { return __hip_atomic_load(p, __ATOMIC_RELAXED, __HIP_MEMORY_SCOPE_AGENT); }
__device__ __forceinline__ unsigned xb_add(unsigned* p, unsigned v) { return __hip_atomic_fetch_add(p, v, __ATOMIC_RELAXED, __HIP_MEMORY_SCOPE_AGENT); }
__device__ __forceinline__ unsigned xb_xcc_id() { return (unsigned)__builtin_amdgcn_s_getreg((3 << 11) | 20) & 0xFu; }
#define XB_SPIN(cond, bar) do { unsigned _sp = 0; while (cond) { __builtin_amdgcn_s_sleep(1); \
    if ((++_sp & 255u) == 0u) { if (xb_ld(&(bar)[XB_TMO])) break; if (_sp > XB_SPIN_CAP) { atomicAdd(&(bar)[XB_TMO], 1u); break; } } } } while (0)

struct XcdBarrier {
    unsigned* bar; unsigned x;
    volatile LAS unsigned* st;
};

__device__ __forceinline__ XcdBarrier xcd_barrier_post(unsigned* bar, volatile LAS unsigned* st) {
    XcdBarrier b; b.bar = bar; b.x = xb_xcc_id(); b.st = st;
    if (threadIdx.x == 0) (void)xb_add(&bar[XB_XCNT(b.x)], 1u);
    return b;
}
__device__ __forceinline__ void xcd_barrier_complete(unsigned* bar, unsigned x, unsigned& nloc, unsigned& nx) {
    const unsigned G = gridDim.x * gridDim.y * gridDim.z;
    unsigned sum, cnt, mine, sp = 0u;
    for (;;) {
        sum = 0u; cnt = 0u; mine = 0u;
#pragma unroll
        for (unsigned j = 0; j < 16; ++j) { const unsigned c = xb_ld(&bar[XB_XCNT(j)]); sum += c; cnt += (c > 0u) ? 1u : 0u; mine = (j == x) ? c : mine; }
        if (sum == G) break;
        __builtin_amdgcn_s_sleep(1);
        if ((++sp & 255u) == 0u) { if (xb_ld(&bar[XB_TMO])) break; if (sp > XB_SPIN_CAP) { atomicAdd(&bar[XB_TMO], 1u); break; } }
    }
    nloc = mine > 0u ? mine : 1u; nx = cnt > 0u ? cnt : 1u;
}

__device__ __forceinline__ void xcd_barrier(const XcdBarrier& b) {
    asm volatile("s_waitcnt vmcnt(0)" ::: "memory");
    __syncthreads();
    if (threadIdx.x == 0) {
        unsigned* bar = b.bar;
        __builtin_amdgcn_s_waitcnt(0);
        unsigned nloc = b.st[0], nx = b.st[1];
        if (nloc == 0u) { xcd_barrier_complete(bar, b.x, nloc, nx); b.st[0] = nloc; b.st[1] = nx; }
        const unsigned old = xb_add(&bar[XB_XSUB(b.x)], 1u);
        const unsigned gen = old / nloc;
        if (old + 1u == (gen + 1u) * nloc) {
            __builtin_amdgcn_fence(__ATOMIC_RELEASE, "agent");
            asm volatile("s_waitcnt vmcnt(0)" ::: "memory");
            const unsigned og = xb_add(&bar[XB_TOP], 1u);
            const unsigned tg = og / nx;
            if (og + 1u == (tg + 1u) * nx) xb_add(&bar[XB_TOPGEN], 1u);
            else XB_SPIN(xb_ld(&bar[XB_TOPGEN]) == tg, bar);
            __builtin_amdgcn_fence(__ATOMIC_ACQUIRE, "agent");
            xb_add(&bar[XB_XGEN(b.x)], 1u);
            asm volatile("s_waitcnt vmcnt(0)" ::: "memory");
        } else {
            XB_SPIN(xb_ld(&bar[XB_XGEN(b.x)]) == gen, bar);
            __builtin_amdgcn_fence(__ATOMIC_ACQUIRE, "agent");
            asm volatile("s_waitcnt vmcnt(0)" ::: "memory");
        }
    }
    __syncthreads();
}

struct Frame {
    LAS unsigned char* lds;
    volatile LAS unsigned* MISC;
    gu32* ctl;
    int tid, lane, wave, vcu, G;
};
__device__ __forceinline__ void frame_refresh(Frame& F, unsigned char* ldsarr) {
    F.lds = (LAS unsigned char*)ldsarr + opaque_zero(); F.tid = opaque_tid(); F.lane = F.tid & 63; F.wave = __builtin_amdgcn_readfirstlane(F.tid >> 6);
}
__device__ __forceinline__ float wave_sum(float v) {
#pragma unroll
    for (int o = 1; o < 64; o <<= 1) v += __shfl_xor(v, o);
    return v;
}
enum { CM_ID = 0, CM_FOX = 1, CM_DIL = 2, CM_UP = 3 };
__device__ __forceinline__ int rope_perm(int j) { return (j & 1) ? 32 + (j >> 1) : (j >> 1); }
__device__ __forceinline__ int colmap(int kind, int n) {
    if (kind == CM_ID) return n;
    if (kind == CM_UP) { const int pn = n >> 8, bj = (n >> 7) & 1, j = n & 127; return bj * FFD + 128 * pn + j; }
    if (kind == CM_FOX) { if (n < 768) return n; if (n < 1024) return 2316 + (n - 768); if (n < 1792) return 768 + (n - 1024); if (n < 2560) return 1536 + (n - 1792); if (n < 2572) return 2304 + (n - 2560); return -1; }
    if (n < 768) return (n & ~63) + rope_perm(n & 63);
    if (n < 1024) return 2304 + (n - 768);
    if (n < 1792) { const int k = n - 1024; return 768 + (k & ~63) + rope_perm(k & 63); }
    return 1536 + (n - 1792);
}
__device__ __forceinline__ void transpose_item(const float* W, int K, int Nsrc, bf16* WT, const float* g, int kind, LAS float* scr, int kb, int nb, int lane) {
    const int k0 = 64 * kb, n0 = 32 * nb;
    const int sc = colmap(kind, n0 + (lane & 31));
#pragma unroll 8
    for (int i = 0; i < 32; ++i) { const int kk = 2 * i + (lane >> 5); float v = 0.f; if (sc >= 0) v = W[(size_t)(k0 + kk) * Nsrc + sc]; if (g) v *= g[k0 + kk]; scr[kk * 33 + (lane & 31)] = v; }
    LDS_WAIT(); asm volatile("" ::: "memory");
    const int c = lane & 7;
#pragma unroll
    for (int j = 0; j < 4; ++j) { const int n = (lane >> 3) + 8 * j; const LAS float* s = scr + (8 * c) * 33 + n;
        v4u o; o.x = pk2(s[0 * 33], s[1 * 33]); o.y = pk2(s[2 * 33], s[3 * 33]); o.z = pk2(s[4 * 33], s[5 * 33]); o.w = pk2(s[6 * 33], s[7 * 33]);
        *(GAS v4u*)(WT + (size_t)(n0 + n) * K + k0 + 8 * c) = o; }
    LDS_WAIT(); asm volatile("" ::: "memory");
}
__device__ __forceinline__ void convert_matrix(Frame& F, const float* W, int K, int Nsrc, bf16* WT, int Ndst, const float* g, int kind) {
    LAS float* scr = (LAS float*)(F.lds + RING_OFF + F.wave * 16384);
    const int gw = F.vcu * NWAVES + F.wave, NGW = F.G * NWAVES, nblk = Ndst / 32, nitems = (K / 64) * nblk;
    for (int it = gw; it < nitems; it += NGW) transpose_item(W, K, Nsrc, WT, g, kind, scr, it / nblk, it % nblk, F.lane);
}

constexpr int PT_OFF = LDSCTL_OFF + 1024;   static_assert(PT_OFF + 17 * 8 <= LDSCTL_BYTES && MISC_OFF + 128 <= PT_OFF, "LDS control map");
enum { PT_X = 0, PT_MEM, PT_NMIX, PT_NMEM, PT_NFFN, PT_WFOX, PT_BFOR, PT_WDIL, PT_WMKV, PT_WOUT, PT_WUP, PT_CW, PT_CB, PT_WDN, PT_NFIN, PT_OUT, PT_WS };
__device__ __forceinline__ GAS unsigned char* ldptr(LAS unsigned char* lds, int i) {
    volatile LAS unsigned* p = (volatile LAS unsigned*)(lds + PT_OFF) + 2 * i;
    const unsigned lo = __builtin_amdgcn_readfirstlane(p[0]), hi = __builtin_amdgcn_readfirstlane(p[1]);
    return (GAS unsigned char*)(((unsigned long long)hi << 32) | lo);
}
#define PTR_F(i) ((const float*)(unsigned char*)ldptr(F.lds, (i)))
struct Args { const float* in[15]; float* out; unsigned char* ws; };
__global__ void __launch_bounds__(NWAVES * 64, 2) mk_fwd(Args args) {
    extern __shared__ __attribute__((aligned(16))) unsigned char lds[];
    Frame F;
    F.lds = (LAS unsigned char*)lds;
    F.MISC = (volatile LAS unsigned*)(F.lds + MISC_OFF);
    F.tid = threadIdx.x; F.lane = F.tid & 63; F.wave = __builtin_amdgcn_readfirstlane(F.tid >> 6);
    F.G = gridDim.x; { const int bx = blockIdx.x; F.vcu = (F.G % 8 == 0) ? (bx % 8) * (F.G / 8) + bx / 8 : bx; }
    F.ctl = (gu32*)(args.ws + WS_CTL);
    for (int u = F.tid; u < LDSCTL_BYTES / 4; u += NWAVES * 64) ((LAS unsigned*)(F.lds + LDSCTL_OFF))[u] = 0u;
    __syncthreads();
    if (F.tid == 0) { LAS unsigned long long* pt = (LAS unsigned long long*)(F.lds + PT_OFF);
#pragma unroll
        for (int i = 0; i < 15; ++i) pt[i] = (unsigned long long)args.in[i];
        pt[PT_OUT] = (unsigned long long)args.out; pt[PT_WS] = (unsigned long long)args.ws; }
    __syncthreads();
    XcdBarrier bar = xcd_barrier_post((unsigned*)(F.ctl + CW_BAR), F.MISC + 8);
#define GRID_BAR() do { XcdBarrier b_ = bar; b_.bar += opaque_zero(); b_.x += (unsigned)opaque_zero(); xcd_barrier(b_); } while (0)

    {
        frame_refresh(F, lds); unsigned char* ws = (unsigned char*)ldptr(F.lds, PT_WS);
        const int gw = F.vcu * NWAVES + F.wave, NGW = F.G * NWAVES, gtid = F.vcu * (NWAVES * 64) + F.tid, NGT = F.G * NWAVES * 64;
#pragma nounroll
        for (int l = 0; l < DEPTH; ++l) {
            bf16* win = (bf16*)(ws + WS_WIN + (size_t)l * WIN_STRIDE);
            if (l & 1) convert_matrix(F, PTR_F(PT_WDIL) + (size_t)(l >> 1) * DMODEL * DIL_IN, DMODEL, DIL_IN, win, 2560, PTR_F(PT_NMIX) + l * DMODEL, CM_DIL);
            else convert_matrix(F, PTR_F(PT_WFOX) + (size_t)(l >> 1) * DMODEL * FOX_IN, DMODEL, FOX_IN, win, 2816, PTR_F(PT_NMIX) + l * DMODEL, CM_FOX);
            convert_matrix(F, PTR_F(PT_WOUT) + (size_t)l * DMODEL * DMODEL, DMODEL, DMODEL, (bf16*)(ws + WS_WOUT + (size_t)l * WOUT_STRIDE), 1024, nullptr, CM_ID);
            convert_matrix(F, PTR_F(PT_WMKV) + (size_t)l * DMODEL * 512, DMODEL, 512, (bf16*)(ws + WS_WMKV) + (size_t)l * 512 * DMODEL, 512, PTR_F(PT_NMEM) + l * DMODEL, CM_ID);
        }
        {
            const float* x = PTR_F(PT_X); float* hres = (float*)(unsigned char*)ldptr(F.lds, PT_OUT); bf16* hb = (bf16*)(ws + WS_HB); float* ssqA = (float*)(ws + WS_SSQA);
            for (int m = gw; m < MTOK; m += NGW) {
                const GAS f32x4* xr = (const GAS f32x4*)(x + (size_t)m * DMODEL) + F.lane; GAS f32x4* hr = (GAS f32x4*)(hres + (size_t)m * DMODEL) + F.lane;
                GAS unsigned long long* o8 = (GAS unsigned long long*)(hb + (size_t)(m + 2) * DMODEL) + F.lane;
                float s = 0.f;
#pragma unroll
                for (int j = 0; j < 4; ++j) { const f32x4 v = xr[64 * j]; s += (v.x * v.x + v.y * v.y) + (v.z * v.z + v.w * v.w); hr[64 * j] = v;
                    o8[64 * j] = (unsigned long long)pk2(v.x, v.y) | ((unsigned long long)pk2(v.z, v.w) << 32); }
                s = wave_sum(s);
                if (F.lane == 0) { ssqA[m] = s; ssqA[MTOK + m] = 0.f; ssqA[2 * MTOK + m] = 0.f; ssqA[3 * MTOK + m] = 0.f; }
            }
            for (int idx = gtid; idx < 258 * 128; idx += NGT) { const int r = idx >> 7, c = idx & 127; const int row = r < 2 ? r : MTOK + r; *(GAS v4u*)(hb + (size_t)row * DMODEL + c * 8) = (v4u){0u, 0u, 0u, 0u}; }
        }
        {
            const float* mem = PTR_F(PT_MEM); bf16* memb = (bf16*)(ws + WS_MEMB); float* rmem = (float*)(ws + WS_RMEM);
            for (int m = gw; m < BATCH * MEMT; m += NGW) {
                const GAS f32x4* xr = (const GAS f32x4*)(mem + (size_t)m * DMODEL) + F.lane; GAS unsigned long long* o8 = (GAS unsigned long long*)(memb + (size_t)m * DMODEL) + F.lane;
                float s = 0.f;
#pragma unroll
                for (int j = 0; j < 4; ++j) { const f32x4 v = xr[64 * j]; s += (v.x * v.x + v.y * v.y) + (v.z * v.z + v.w * v.w);
                    o8[64 * j] = (unsigned long long)pk2(v.x, v.y) | ((unsigned long long)pk2(v.z, v.w) << 32); }
                s = wave_sum(s);
                if (F.lane == 0) rmem[m] = 1.0f / sqrtf(s * (1.0f / DMODEL) + 1e-6f);
            }
        }
        {
            float* rope = (float*)(ws + WS_ROPE);
            for (int idx = gtid; idx < SEQ * 32; idx += NGT) { const int pos = idx >> 5, i = idx & 31;
                const float inv = (float)exp(-(double)(2 * i) / 64.0 * 9.210340371976184); const float ang = (float)pos * inv; float sn, cs; sincosf(ang, &sn, &cs);
                rope[idx] = cs; rope[SEQ * 32 + idx] = sn; }
        }
    }
    GRID_BAR();

#pragma nounroll
    for (int layer = 0; layer < DEPTH; ++layer) {
        const int dil = layer & 1, slot = layer >> 1;
        {
            frame_refresh(F, lds); unsigned char* ws = (unsigned char*)ldptr(F.lds, PT_WS);
            pg8::Gemm g{(const pg8::bf16_t*)(ws + WS_HB) + 2 * DMODEL, (const pg8::bf16_t*)(ws + WS_WIN + (size_t)layer * WIN_STRIDE), DMODEL, 0};
            pg8::StaticOrder S; S.init(64, dil ? 10 : 11, F.G, (int)blockIdx.x);
            pg8::EpiInProj E{(pg8::bf16_t*)(ws + WS_QO), (pg8::bf16_t*)(ws + WS_K), (pg8::bf16_t*)(ws + WS_V), (float*)(ws + WS_FLOG), (const float*)(ws + WS_SSQA), PTR_F(PT_BFOR) + slot * NMIX, (const float*)(ws + WS_ROPE), dil};
#ifndef NO_INPROJ
            pg8::gemm_phase<pg8::EpiInProj, pg8::StaticOrder, PG8_ALIGN, PG8_SP2>(F.lds + RING_OFF, g, S, E);
#endif
        }
        if (layer == 0) {
            frame_refresh(F, lds); unsigned char* ws = (unsigned char*)ldptr(F.lds, PT_WS);
            pg8::Gemm g2{(const pg8::bf16_t*)(ws + WS_MEMB), (const pg8::bf16_t*)(ws + WS_WMKV), DMODEL, 0};
            pg8::StaticOrder S2; S2.init(4, 8, F.G, ((int)blockIdx.x + 64) & 255);
            pg8::EpiMemKV E2{(pg8::bf16_t*)(ws + WS_KVM), (const float*)(ws + WS_RMEM)};
#ifndef NO_MEMKV
            pg8::gemm_phase<pg8::EpiMemKV, pg8::StaticOrder, PG8_ALIGN, PG8_SP2>(F.lds + RING_OFF, g2, S2, E2);
#endif
        }
        GRID_BAR();
        {
            frame_refresh(F, lds); unsigned char* ws = (unsigned char*)ldptr(F.lds, PT_WS);
            convert_matrix(F, PTR_F(PT_WUP) + (size_t)layer * DMODEL * FF2, DMODEL, FF2, (bf16*)(ws + WS_WUP), FF2, PTR_F(PT_NFFN) + layer * DMODEL, CM_UP);
            convert_matrix(F, PTR_F(PT_WDN) + (size_t)layer * FFD * DMODEL, FFD, DMODEL, (bf16*)(ws + WS_WDN), DMODEL, nullptr, CM_ID);
        }
        __syncthreads();
#pragma nounroll
        for (int sub = 0; sub < 1 + dil; ++sub) {
            const int kind = dil ? 1 + sub : 0;
            const int nun = kind == 1 ? 6 : 4;
#pragma nounroll
            for (int i = 0; i < nun; ++i) {
                typedef attn_body::bf16 abf;
                frame_refresh(F, lds); const unsigned char* ws = (unsigned char*)ldptr(F.lds, PT_WS);
                attn_body::AttnDesc U; int bh = 0;
                U.ws = ws; U.fox = 0; U.mode = 0; U.lse = nullptr; U.lstride = 0; U.mrg_off = 0; U.lse_off = 0; U.qadd = 0; U.W = 128; U.t_lo = 0; U.NT = 4; U.q0 = 0;
                const abf* QOa = (const abf*)(ws + WS_QO); const abf* KBa = (const abf*)(ws + WS_K); const abf* VBa = (const abf*)(ws + WS_V);
                const int v = F.vcu;
                if ((kind != 1) && i == 3) {
                    const int b = v >> 6, hm = (v >> 4) & 3, qb = v & 15;
                    U.Q = QOa + (size_t)(b * SEQ) * 1024 + (12 + hm) * 64; U.O = (abf*)U.Q; U.qstride = 1024; U.ostride = 1024;
                    U.K = (const abf*)(ws + WS_KVM) + (size_t)(b * MEMT) * 2048 + 512 * layer + 64 * hm; U.V = U.K + 256; U.kstride = 2048;
                    U.q0 = 256 * qb; U.W = 0x7fffffff; U.qadd = 1 << 20;
                } else if (kind == 0) {
                    const int g = v >> 4, ii = v & 15; bh = 3 * g + i; const int qb = i == 0 ? ii : (i == 1 ? ((ii + 8) & 15) : (ii < 8 ? 15 - 2 * ii : 30 - 2 * ii));
                    const int b = bh / NMIX, h = bh % NMIX;
                    U.Q = QOa + (size_t)(b * SEQ) * 1024 + h * 64; U.O = (abf*)U.Q; U.qstride = 1024; U.ostride = 1024;
                    U.K = KBa + (size_t)(b * SEQ) * 768 + h * 64; U.V = VBa + (size_t)(b * SEQ) * 768 + h * 64; U.kstride = 768;
                    U.q0 = 256 * qb; U.NT = 4 * qb + 4; U.W = 0x7fffffff; U.fox = 1;
                } else if (kind == 1 && i < 3) {
                    const int e = v + 256 * i, r = e & 15; bh = e >> 4; const int b = bh / NMIX, h = bh % NMIX;
                    U.Q = QOa + (size_t)(b * SEQ + r) * 1024 + h * 64; U.qstride = 16 * 1024;
                    U.O = (abf*)(ws + WS_OB16) + (size_t)(b * SEQ + r) * 768 + h * 64; U.ostride = 16 * 768;
                    U.K = KBa + (size_t)(b * SEQ + r) * 768 + h * 64; U.V = VBa + (size_t)(b * SEQ + r) * 768 + h * 64; U.kstride = 16 * 768;
                    U.mode = 1; U.lse = (float*)(ws + WS_LSE16) + (size_t)bh * SEQ + r; U.lstride = 16;
                } else if (kind == 1) {
                    const int k = i - 3, e = v + 256 * k, qb = ((v & 3) + k) & 3, rest = e >> 2, r = rest & 3; bh = rest >> 2; const int b = bh / NMIX, h = bh % NMIX;
                    U.Q = QOa + (size_t)(b * SEQ + r) * 1024 + h * 64; U.qstride = 4 * 1024;
                    U.O = (abf*)(ws + WS_OB4) + (size_t)(b * SEQ + r) * 768 + h * 64; U.ostride = 4 * 768;
                    U.K = KBa + (size_t)(b * SEQ + r) * 768 + h * 64; U.V = VBa + (size_t)(b * SEQ + r) * 768 + h * 64; U.kstride = 4 * 768;
                    U.q0 = 256 * qb; U.t_lo = qb ? 4 * qb - 2 : 0; U.NT = qb ? 6 : 4;
                    U.mode = 1; U.lse = (float*)(ws + WS_LSE4) + (size_t)bh * SEQ + r; U.lstride = 4;
                } else {
                    const int e = v + 256 * i, qb = e & 15; bh = e >> 4; const int b = bh / NMIX, h = bh % NMIX;
                    U.Q = QOa + (size_t)(b * SEQ) * 1024 + h * 64; U.O = (abf*)U.Q; U.qstride = 1024; U.ostride = 1024;
                    U.K = KBa + (size_t)(b * SEQ) * 768 + h * 64; U.V = VBa + (size_t)(b * SEQ) * 768 + h * 64; U.kstride = 768;
                    U.q0 = 256 * qb; U.t_lo = qb ? 4 * qb - 2 : 0; U.NT = qb ? 6 : 4;
                    U.mode = 2; U.mrg_off = (b * SEQ) * 768 + h * 64; U.lse_off = bh * SEQ;
                }
                if (U.fox) attn_body::fox_scan((const float*)(ws + WS_FLOG) + (size_t)bh * SEQ, (char*)F.lds + RING_OFF);
#ifndef NO_ATTN
                attn_body::attn_unit<8>(U, (char*)F.lds + RING_OFF);
#endif
            }
            GRID_BAR();
        }
        {
            frame_refresh(F, lds); unsigned char* ws = (unsigned char*)ldptr(F.lds, PT_WS);
            pg8::Gemm g{(const pg8::bf16_t*)(ws + WS_QO), (const pg8::bf16_t*)(ws + WS_WOUT + (size_t)layer * WOUT_STRIDE), DMODEL, 0};
            pg8::StaticOrder S; S.init(64, 4, F.G, (int)blockIdx.x);
            pg8::EpiResid E{(float*)(unsigned char*)ldptr(F.lds, PT_OUT), (pg8::bf16_t*)(ws + WS_HB), (float*)(ws + WS_SSQB)};
#ifndef NO_RESID
            pg8::gemm_phase<pg8::EpiResid, pg8::StaticOrder, false, PG8_SP2>(F.lds + RING_OFF, g, S, E);
#endif
        }
        GRID_BAR();
        {
            frame_refresh(F, lds); unsigned char* ws = (unsigned char*)ldptr(F.lds, PT_WS);
            pg8::Gemm g{(const pg8::bf16_t*)(ws + WS_HB), (const pg8::bf16_t*)(ws + WS_WUP), DMODEL, 1};
            pg8::StaticOrder S; S.init(68, 22, F.G, (int)blockIdx.x);
            pg8::EpiUpConv E{(pg8::bf16_t*)(ws + WS_ACT), (const float*)(ws + WS_SSQB), PTR_F(PT_CW) + (size_t)layer * 3 * FF2, PTR_F(PT_CB) + (size_t)layer * FF2};
#ifndef NO_UP
            pg8::gemm_phase<pg8::EpiUpConv, pg8::StaticOrder, PG8_ALIGN, PG8_SP2>(F.lds + RING_OFF, g, S, E);
#endif
        }
        GRID_BAR();
        {
            frame_refresh(F, lds); unsigned char* ws = (unsigned char*)ldptr(F.lds, PT_WS);
            pg8::Gemm g{(const pg8::bf16_t*)(ws + WS_ACT), (const pg8::bf16_t*)(ws + WS_WDN), FFD, 0};
            pg8::StaticOrder S; S.init(64, 4, F.G, (int)blockIdx.x);
            pg8::EpiResid E{(float*)(unsigned char*)ldptr(F.lds, PT_OUT), (pg8::bf16_t*)(ws + WS_HB), (float*)(ws + WS_SSQA)};
#ifndef NO_RESID
            pg8::gemm_phase<pg8::EpiResid, pg8::StaticOrder, false, PG8_SP2>(F.lds + RING_OFF, g, S, E);
#endif
        }
        GRID_BAR();
    }
    {
        frame_refresh(F, lds); const int gw = F.vcu * NWAVES + F.wave, NGW = F.G * NWAVES; float* hres = (float*)(unsigned char*)ldptr(F.lds, PT_OUT); const float* ssqA = (const float*)((unsigned char*)ldptr(F.lds, PT_WS) + WS_SSQA); const float* nf = PTR_F(PT_NFIN);
        for (int m = gw; m < MTOK; m += NGW) {
            GAS f32x4* hr = (GAS f32x4*)(hres + (size_t)m * DMODEL) + F.lane; const GAS f32x4* gr = (const GAS f32x4*)nf + F.lane;
            const float rt = pg8::row_rstd(ssqA, m);
#pragma unroll
            for (int j = 0; j < 4; ++j) { const f32x4 v = hr[64 * j], gg = gr[64 * j]; hr[64 * j] = v * rt * gg; }
        }
    }
}

extern "C" void kernel_launch(void* const* d_in, const int* in_sizes, int n_in, void* d_out, int out_size, void* d_ws, size_t ws_size, hipStream_t stream) {
    static int grid = 0;
    if (grid == 0) {
        if (n_in != 15 || in_sizes[0] != MTOK * DMODEL || out_size != MTOK * DMODEL || ws_size < WS_END) { fprintf(stderr, "kernel_launch: unexpected shapes / workspace (%d inputs, ws %zu)\n", n_in, ws_size); grid = -1; return; }
        int dev = 0, cus = 0, per_cu = 0;
        if (hipGetDevice(&dev) != hipSuccess || hipDeviceGetAttribute(&cus, hipDeviceAttributeMultiprocessorCount, dev) != hipSuccess) { grid = -1; return; }
        if (hipFuncSetAttribute((const void*)mk_fwd, hipFuncAttributeMaxDynamicSharedMemorySize, LDS_BYTES) != hipSuccess) { fprintf(stderr, "kernel_launch: hipFuncSetAttribute failed\n"); grid = -1; return; }
        if (hipOccupancyMaxActiveBlocksPerMultiprocessor(&per_cu, (const void*)mk_fwd, NWAVES * 64, LDS_BYTES) != hipSuccess || per_cu < 1) fprintf(stderr, "kernel_launch: occupancy query reports %d blocks per CU\n", per_cu);
        (void)hipGetLastError();
        grid = cus;
        if (grid != 256) fprintf(stderr, "kernel_launch: %d CUs; this kernel is built for 256\n", grid);
    }
    if (grid < 0) return;
    if (hipMemsetAsync((char*)d_ws + WS_CTL, 0, CTL_ZERO_BYTES, stream) != hipSuccess) return;
    Args a{};
    for (int i = 0; i < 15; ++i) a.in[i] = (const float*)d_in[i];
    a.out = (float*)d_out; a.ws = (unsigned char*)d_ws;
    hipLaunchKernelGGL(mk_fwd, dim3(grid), dim3(NWAVES * 64), LDS_BYTES, stream, a);
}
```

```cpp
#include <hip/hip_runtime.h>
#include <hip/hip_bf16.h>
#include <cstdio>
#include <cstdint>
#include <cmath>

constexpr int NWAVES = 8, GRID = 256;
constexpr int BATCH = 4, SEQ = 4096, DMODEL = 1024, MTOK = BATCH * SEQ, DEPTH = 4, NMIX = 12, FFD = 2816, FF2 = 2 * FFD, MEMT = 256;
constexpr int FOX_IN = 2572, DIL_IN = 2560;
constexpr size_t MiB = 1u << 20;
constexpr size_t WS_CTL = 0, CTL_ZERO_BYTES = 1 * MiB;
constexpr size_t WS_ROPE = 1 * MiB;
constexpr size_t WS_SSQA = 2 * MiB, WS_SSQB = 2 * MiB + 256 * 1024;
constexpr size_t WS_RMEM = 2 * MiB + 512 * 1024;
constexpr size_t WS_FLOG = 3 * MiB;
constexpr size_t WS_LSE4 = 4 * MiB, WS_LSE16 = 5 * MiB;
constexpr size_t WS_MEMB = 6 * MiB;
constexpr size_t WS_KVM = 8 * MiB;
constexpr size_t WS_WIN = 12 * MiB, WIN_STRIDE = (size_t)2816 * 1024 * 2;
constexpr size_t WS_WOUT = 34 * MiB, WOUT_STRIDE = (size_t)1024 * 1024 * 2;
constexpr size_t WS_WUP = 42 * MiB;
constexpr size_t WS_WDN = 53 * MiB;
constexpr size_t WS_WMKV = 59 * MiB;
constexpr size_t WS_HB = 64 * MiB;
constexpr size_t WS_OB4 = WS_HB + 4096;
constexpr size_t WS_QO = 97 * MiB, WS_K = 129 * MiB, WS_V = 153 * MiB;
constexpr size_t WS_ACT = 97 * MiB;
constexpr size_t WS_OB16 = 185 * MiB;
constexpr size_t WS_END = 209 * MiB;
static_assert(WS_HB + (size_t)(2 + MTOK + 256) * 2048 <= WS_QO && WS_ACT + (size_t)MTOK * FFD * 2 <= WS_OB16 && WS_V + (size_t)MTOK * 768 * 2 <= WS_OB16, "d_ws map");
constexpr int CW_TMO = 0, CW_CODE = 1, CW_BAR = 4096;

__device__ __forceinline__ int opaque_tid() { int t = threadIdx.x; asm volatile("" : "+v"(t)); return t; }
__device__ __forceinline__ int opaque_zero() { int z = 0; asm volatile("" : "+s"(z)); return z; }

namespace pg8 {
#define PG8_LAS __attribute__((address_space(3)))
typedef unsigned short bf16_t;
typedef short bf16x8 __attribute__((ext_vector_type(8)));
typedef float f32x4 __attribute__((ext_vector_type(4)));
typedef unsigned u32x4 __attribute__((ext_vector_type(4)));
constexpr int BM = 256, BK = 64, HALF = 128, HTB = HALF * BK * 2  , STAGE_BYTES = 8 * HTB, NXCD = 8, WGM = 8;

__host__ __device__ __forceinline__ int lds_byte(int r, int c) { const int st = (r >> 4) * 2 + (c >> 5), rr = r & 15, cc = c & 31, ob = rr * 64 + cc * 2; return st * 1024 + (ob ^ (((ob >> 9) & 1) << 5)); }
__host__ __device__ __forceinline__ void stage_rc(int b, int& R, int& C) { const int st = b / 1024, sb = b % 1024, swz = sb ^ (((sb >> 9) & 1) << 5); R = (st >> 1) * 16 + swz / 64; C = (st & 1) * 32 + (swz % 64) / 2; }
__host__ __device__ __forceinline__ int perm32(int rho) { const int n = rho >> 4, i = rho & 15; return 8 * (i >> 2) + 4 * n + (i & 3); }

constexpr int MROWS = 16384;
struct Unit { int pm, pn; };
struct Gemm { const bf16_t* A; const bf16_t* Bt; int K; int halo;
    __device__ __forceinline__ int arow(int R) const { return halo ? 62 * (R >> 6) + (R & 63) : R; }
    __device__ __forceinline__ int arow_half() const { return halo ? 124 : 128; }
    __device__ __forceinline__ size_t a_off(int pm) const { return halo ? (size_t)((pm / 17) * 4096 + 248 * (pm % 17)) * (size_t)K * 2 : (size_t)pm * 256 * (size_t)K * 2; }
};
struct StaticOrder {
    int nM, nN, nwg, G, c;
    __host__ __device__ void init(int nM_, int nN_, int G_, int c_) { nM = nM_; nN = nN_; nwg = nM * nN; G = G_; c = c_; }
    __host__ __device__ bool next(int i, Unit& u) const {
        const long L = (long)i * G + c; if (L >= nwg) return false;
        int wgid = (int)L; { const int q = nwg / NXCD, r = nwg % NXCD, xcd = wgid % NXCD, off = wgid / NXCD; wgid = (xcd < r ? xcd * (q + 1) : r * (q + 1) + (xcd - r) * q) + off; }
        const int nig = WGM * nN, gid = wgid / nig, fm = gid * WGM, gsz = (nM - fm) < WGM ? (nM - fm) : WGM;
        u.pm = fm + ((wgid % nig) % gsz); u.pn = (wgid % nig) / gsz; return true;
    }
    __device__ __forceinline__ void a_ready(const Unit&) const {}
    __device__ __forceinline__ void done(const Unit&) const {}
};

__device__ __forceinline__ unsigned cvt_pk_bf16(float lo, float hi) { unsigned r; asm volatile("v_cvt_pk_bf16_f32 %0, %1, %2" : "=v"(r) : "v"(lo), "v"(hi)); return r; }
typedef float f32x2 __attribute__((ext_vector_type(2)));
typedef unsigned u32x2 __attribute__((ext_vector_type(2)));
constexpr float QSCALE = 0.125f * 1.4426950408889634f;
__device__ __forceinline__ float row_rstd(const float* ssq, int row) {
    const float s = (ssq[row] + ssq[MROWS + row]) + (ssq[2 * MROWS + row] + ssq[3 * MROWS + row]);
    return 1.0f / sqrtf(s * (1.0f / 1024.0f) + 1e-6f);
}
__device__ __forceinline__ float logsig(float x) { const float e = __builtin_amdgcn_exp2f(-1.4426950408889634f * fabsf(x)); return fminf(x, 0.f) - 0.6931471805599453f * __builtin_amdgcn_logf(1.0f + e); }

struct EpiInProj {
    static constexpr bool PERM = true, AFTER_DRAIN = false;
    bf16_t *Q, *Kb, *Vb; float* flog; const float* ssq; const float* bfor; const float* rope; int dil;
    __device__ __forceinline__ void operator()(const f32x4 (&acc)[2][2][4][2], const Unit& u, int wr, int wc, int fr, int fq) const {
        const int row0 = u.pm * BM + wr * 64 + fr, pn = u.pn;
        if (pn == 10) {
            if (wc == 0) {
#pragma unroll
                for (int ai = 0; ai < 2; ++ai)
#pragma unroll
                    for (int m = 0; m < 4; ++m) { const int row = row0 + ai * HALF + m * 16; const float rt = row_rstd(ssq, row); const int b = row >> 12, s = row & 4095;
                        const f32x4 v0 = acc[ai][0][m][0], v1 = acc[ai][0][m][1];
                        if (fq == 0) {
#pragma unroll
                            for (int e = 0; e < 4; ++e) { flog[(size_t)(b * 12 + e) * 4096 + s] = logsig(v0[e] * rt + bfor[e]); flog[(size_t)(b * 12 + 4 + e) * 4096 + s] = logsig(v1[e] * rt + bfor[4 + e]); }
                        } else if (fq == 1) {
#pragma unroll
                            for (int e = 0; e < 4; ++e) flog[(size_t)(b * 12 + 8 + e) * 4096 + s] = logsig(v0[e] * rt + bfor[8 + e]);
                        } }
            }
            return;
        }
        bf16_t* base; int ldc, colt; float sc = 1.f; bool rp;
        if (pn < 4) { base = Q; ldc = 1024; colt = pn * 256; sc = QSCALE; rp = dil && pn < 3; }
        else if (pn < 7) { base = Kb; ldc = 768; colt = (pn - 4) * 256; rp = dil != 0; }
        else { base = Vb; ldc = 768; colt = (pn - 7) * 256; rp = false; }
        const int col0 = colt + wc * 32 + 8 * fq, i0 = (16 * wc + 4 * fq) & 31;
#pragma unroll
        for (int ai = 0; ai < 2; ++ai)
#pragma unroll
            for (int m = 0; m < 4; ++m) { const int row = row0 + ai * HALF + m * 16; const float rt = row_rstd(ssq, row) * sc; const int pos = row & 4095;
                f32x4 cs = (f32x4){1.f, 1.f, 1.f, 1.f}, sn = (f32x4){0.f, 0.f, 0.f, 0.f};
                if (rp) { cs = *(const f32x4*)(rope + pos * 32 + i0); sn = *(const f32x4*)(rope + 4096 * 32 + pos * 32 + i0); }
                bf16_t* rowp = base + (size_t)row * ldc + col0;
#pragma unroll
                for (int bj = 0; bj < 2; ++bj) { f32x4 v0 = acc[ai][bj][m][0] * rt, v1 = acc[ai][bj][m][1] * rt;
                    if (rp) { const f32x4 a = v0, b = v1;
                        v0[0] = a[0] * cs[0] - a[1] * sn[0]; v0[1] = a[1] * cs[0] + a[0] * sn[0]; v0[2] = a[2] * cs[1] - a[3] * sn[1]; v0[3] = a[3] * cs[1] + a[2] * sn[1];
                        v1[0] = b[0] * cs[2] - b[1] * sn[2]; v1[1] = b[1] * cs[2] + b[0] * sn[2]; v1[2] = b[2] * cs[3] - b[3] * sn[3]; v1[3] = b[3] * cs[3] + b[2] * sn[3]; }
                    u32x4 w; w.x = cvt_pk_bf16(v0[0], v0[1]); w.y = cvt_pk_bf16(v0[2], v0[3]); w.z = cvt_pk_bf16(v1[0], v1[1]); w.w = cvt_pk_bf16(v1[2], v1[3]);
                    *(u32x4*)(rowp + bj * HALF) = w; } }
    }
};
struct EpiMemKV {
    static constexpr bool PERM = true, AFTER_DRAIN = false;
    bf16_t* O; const float* rmem;
    __device__ __forceinline__ void operator()(const f32x4 (&acc)[2][2][4][2], const Unit& u, int wr, int wc, int fr, int fq) const {
        const int row0 = u.pm * BM + wr * 64 + fr, col0 = u.pn * BM + wc * 32 + 8 * fq;
#pragma unroll
        for (int ai = 0; ai < 2; ++ai)
#pragma unroll
            for (int m = 0; m < 4; ++m) { const int row = row0 + ai * HALF + m * 16; const float rt = rmem[row]; bf16_t* rowp = O + (size_t)row * 2048 + col0;
#pragma unroll
                for (int bj = 0; bj < 2; ++bj) { const f32x4 v0 = acc[ai][bj][m][0] * rt, v1 = acc[ai][bj][m][1] * rt;
                    u32x4 w; w.x = cvt_pk_bf16(v0[0], v0[1]); w.y = cvt_pk_bf16(v0[2], v0[3]); w.z = cvt_pk_bf16(v1[0], v1[1]); w.w = cvt_pk_bf16(v1[2], v1[3]);
                    *(u32x4*)(rowp + bj * HALF) = w; } }
    }
};
struct EpiResid {
    static constexpr bool PERM = false, AFTER_DRAIN = true;
    float* h; bf16_t* hb; float* ssq;
    __device__ __forceinline__ void fused(const f32x4 (&acc)[2][2][4][2], const Unit& u, int wr, int wc, int fr, int fq, PG8_LAS unsigned char* lds, int wid, int lane) const {
        PG8_LAS float* P = (PG8_LAS float*)lds;
        const int col0 = u.pn * BM + wc * 32 + 4 * fq;
#pragma unroll
        for (int ai = 0; ai < 2; ++ai)
#pragma unroll
            for (int m = 0; m < 4; ++m) { const int rt_ = ai * HALF + wr * 64 + m * 16 + fr; const size_t off = (size_t)(u.pm * BM + rt_) * 1024 + col0; float s = 0.f;
#pragma unroll
                for (int bj = 0; bj < 2; ++bj)
#pragma unroll
                    for (int n = 0; n < 2; ++n) { const f32x4 bs = *(const f32x4*)(h + off + bj * HALF + n * 16); const f32x4 o = bs + acc[ai][bj][m][n];
                        *(f32x4*)(h + off + bj * HALF + n * 16) = o; s += (o[0] * o[0] + o[1] * o[1]) + (o[2] * o[2] + o[3] * o[3]);
                        u32x2 w; w.x = cvt_pk_bf16(o[0], o[1]); w.y = cvt_pk_bf16(o[2], o[3]); *(u32x2*)(hb + off + 2048 + bj * HALF + n * 16) = w; }
                s += __shfl_xor(s, 16); s += __shfl_xor(s, 32);
                if (fq == 0) P[rt_ * 4 + wc] = s;
                if (m & 1) asm volatile("" ::: "memory"); }
        asm volatile("s_waitcnt lgkmcnt(0)" ::: "memory"); __builtin_amdgcn_s_barrier(); asm volatile("" ::: "memory");
        const int tid = wid * 64 + lane;
        if (tid < 256) { const float s = (P[tid * 4 + 0] + P[tid * 4 + 1]) + (P[tid * 4 + 2] + P[tid * 4 + 3]); ssq[(size_t)u.pn * MROWS + u.pm * BM + tid] = s; }
    }
};
template <int CTRL, bool BC> __device__ __forceinline__ float dppf(float old, float src) {
    return __builtin_bit_cast(float, __builtin_amdgcn_update_dpp(__builtin_bit_cast(int, old), __builtin_bit_cast(int, src), CTRL, 0xf, 0xf, BC)); }
struct EpiUpConv {
    static constexpr bool PERM = true, AFTER_DRAIN = false;
    bf16_t* act; const float* ssq; const float* cw; const float* cb;
    __device__ __forceinline__ void operator()(const f32x4 (&acc)[2][2][4][2], const Unit& u, int wr, int wc, int fr, int fq) const {
        const int b = u.pm / 17, j = u.pm % 17, T0 = b * 4096 + 248 * j;
        const int ch0 = 128 * u.pn + 32 * wc + 8 * fq;
        float rts[2][4];
#pragma unroll
        for (int ai = 0; ai < 2; ++ai)
#pragma unroll
            for (int m = 0; m < 4; ++m) { const int tok = T0 + 62 * (2 * ai + wr) + 16 * m + fr - 2; const int local = tok - b * 4096; const int tokc = tok < 0 ? 0 : (tok > MROWS - 1 ? MROWS - 1 : tok);
                rts[ai][m] = local < 0 ? 0.f : row_rstd(ssq, tokc); }
        u32x2 lo[2][4];
#pragma unroll
        for (int n = 0; n < 2; ++n) {
            f32x4 w[3][2], bb[2];
#pragma unroll
            for (int bj = 0; bj < 2; ++bj) { bb[bj] = *(const f32x4*)(cb + bj * 2816 + ch0 + 4 * n);
#pragma unroll
                for (int tp = 0; tp < 3; ++tp) w[tp][bj] = *(const f32x4*)(cw + tp * 5632 + bj * 2816 + ch0 + 4 * n); }
#pragma unroll
            for (int ai = 0; ai < 2; ++ai) { f32x4 pv[2];
#pragma unroll
                for (int m = 0; m < 4; ++m) { const int rho = 16 * m + fr, tok = T0 + 62 * (2 * ai + wr) + rho - 2, local = tok - b * 4096;
                    f32x4 uv[2], c[2];
#pragma unroll
                    for (int bj = 0; bj < 2; ++bj) { uv[bj] = acc[ai][bj][m][n] * rts[ai][m];
#pragma unroll
                        for (int e = 0; e < 4; ++e) { float s1 = dppf<0x111, true>(0.f, uv[bj][e]), s2 = dppf<0x112, true>(0.f, uv[bj][e]);
                            if (m > 0) { s1 = dppf<0x10F, false>(s1, pv[bj][e]); s2 = dppf<0x10E, false>(s2, pv[bj][e]); }
                            c[bj][e] = bb[bj][e] + w[0][bj][e] * s2 + w[1][bj][e] * s1 + w[2][bj][e] * uv[bj][e]; }
                        pv[bj] = uv[bj]; }
                    float o[4];
#pragma unroll
                    for (int e = 0; e < 4; ++e) { const float gt = c[1][e]; o[e] = gt * __builtin_amdgcn_rcpf(1.0f + __builtin_amdgcn_exp2f(-1.4426950408889634f * gt)) * c[0][e]; }
                    u32x2 pk; pk.x = cvt_pk_bf16(o[0], o[1]); pk.y = cvt_pk_bf16(o[2], o[3]);
                    if (n == 0) lo[ai][m] = pk;
                    else if (rho >= 2 && local < 4096) { u32x4 st; st.x = lo[ai][m].x; st.y = lo[ai][m].y; st.z = pk.x; st.w = pk.y; *(u32x4*)(act + (size_t)tok * 2816 + ch0) = st; }
                } }
        }
    }
};

template <class Epi, class Sched, bool ALIGN_EPI = false, bool SP2 = false>
__device__ __forceinline__ void gemm_phase(PG8_LAS unsigned char* lds, const Gemm g, const Sched& S, const Epi& E) {
    const int tid = opaque_tid(), wid = __builtin_amdgcn_readfirstlane(tid >> 6), lane = tid & 63, wr = wid >> 2, wc = wid & 3, fr = lane & 15, fq = lane >> 4;
    const int K = g.K, nt = K / BK;
    unsigned voffA[2], voffB[2];
#pragma unroll
    for (int i = 0; i < 2; ++i) { int R, C; stage_rc(tid * 16 + i * 8192, R, C); const int Rb = Epi::PERM ? ((R & ~31) + perm32(R & 31)) : R;
        voffA[i] = (unsigned)(g.arow(R) * K + C) * 2u; voffB[i] = (unsigned)(Rb * K + C) * 2u; }
    const size_t kstep = (size_t)(BK * 2);
    const size_t hstep = (size_t)HALF * K * 2; const size_t hstepA = (size_t)g.arow_half() * K * 2;
    const size_t tstep = 2 * hstep;
    const unsigned ldsw = (unsigned)wid * 1024u;
    const int aoff = lds_byte(wr * 64 + fr, fq * 8), boff = lds_byte(wc * 32 + fr, fq * 8);
#define PG8_SA(b, h) (((b) * 2 + (h)) * HTB)
#define PG8_SB(b, h) ((4 + (b) * 2 + (h)) * HTB)
#define PG8_STAGE(bufoff, gbase, voff) do { _Pragma("unroll") for (int _i = 0; _i < 2; ++_i) \
        __builtin_amdgcn_global_load_lds((const unsigned*)((const char*)(gbase) + (voff)[_i]), (PG8_LAS unsigned*)(lds + (bufoff) + ldsw + _i * 8192), 16, 0, 0); } while (0)
#define PG8_LDA(dst, b, h) do { _Pragma("unroll") for (int m = 0; m < 4; ++m) _Pragma("unroll") for (int k = 0; k < 2; ++k) dst[m][k] = *(const PG8_LAS bf16x8*)(lds + PG8_SA(b, h) + aoff + m * 2048 + k * 1024); } while (0)
#define PG8_LDB(dst, b, h) do { _Pragma("unroll") for (int n = 0; n < 2; ++n) _Pragma("unroll") for (int k = 0; k < 2; ++k) dst[n][k] = *(const PG8_LAS bf16x8*)(lds + PG8_SB(b, h) + boff + n * 2048 + k * 1024); } while (0)
#define PG8_MMA(ai, bj, At, Bt) do { __builtin_amdgcn_s_setprio(1); _Pragma("unroll") for (int m = 0; m < 4; ++m) _Pragma("unroll") for (int n = 0; n < 2; ++n) _Pragma("unroll") for (int k = 0; k < 2; ++k) \
        acc[ai][bj][m][n] = __builtin_amdgcn_mfma_f32_16x16x32_bf16(Bt[n][k], At[m][k], acc[ai][bj][m][n], 0, 0, 0); __builtin_amdgcn_s_setprio(0); } while (0)
#define PG8_WAIT_V(n) asm volatile("s_waitcnt vmcnt(" #n ")" ::: "memory")
#define PG8_WAIT_L(n) asm volatile("s_waitcnt lgkmcnt(" #n ")" ::: "memory")
#define PG8_BAR __builtin_amdgcn_s_barrier()
#define PG8_SCHED __builtin_amdgcn_sched_barrier(0)
    Unit cur, nxt; int ui = 0;
    if (!S.next(0, cur)) return;
    f32x4 acc[2][2][4][2];
#pragma unroll
    for (int a = 0; a < 2; ++a)
#pragma unroll
        for (int b = 0; b < 2; ++b)
#pragma unroll
            for (int m = 0; m < 4; ++m)
#pragma unroll
                for (int n = 0; n < 2; ++n) acc[a][b][m][n] = (f32x4){0.f, 0.f, 0.f, 0.f};
    bf16x8 At[4][2], B0[2][2], B1[2][2];
    const char* cA = (const char*)g.A + g.a_off(cur.pm); const char* cB = (const char*)g.Bt + (size_t)cur.pn * tstep;
    S.a_ready(cur);
    if constexpr (SP2) {
        PG8_STAGE(PG8_SB(0, 0), cB, voffB); PG8_STAGE(PG8_SB(0, 1), cB + hstep, voffB); PG8_STAGE(PG8_SA(0, 0), cA, voffA); PG8_STAGE(PG8_SA(0, 1), cA + hstepA, voffA);
        if (wr == 1) PG8_BAR;
        PG8_WAIT_V(2); PG8_BAR;
        PG8_STAGE(PG8_SB(1, 0), cB + kstep, voffB); PG8_STAGE(PG8_SA(1, 0), cA + kstep, voffA); PG8_STAGE(PG8_SB(1, 1), cB + hstep + kstep, voffB);
        PG8_WAIT_V(6); PG8_BAR;
    } else {
        PG8_STAGE(PG8_SB(0, 0), cB, voffB); PG8_STAGE(PG8_SA(0, 0), cA, voffA); PG8_STAGE(PG8_SB(0, 1), cB + hstep, voffB); PG8_STAGE(PG8_SA(0, 1), cA + hstepA, voffA);
        if (wr == 1) PG8_BAR;
        PG8_WAIT_V(4); PG8_BAR;
        PG8_STAGE(PG8_SB(1, 0), cB + kstep, voffB); PG8_STAGE(PG8_SA(1, 0), cA + kstep, voffA); PG8_STAGE(PG8_SB(1, 1), cB + hstep + kstep, voffB);
        PG8_WAIT_V(6); PG8_BAR;
    }
    for (;;) {
        const bool has_next = S.next(ui + 1, nxt);
        const char* nA = has_next ? (const char*)g.A + g.a_off(nxt.pm) : cA; const char* nB = has_next ? (const char*)g.Bt + (size_t)nxt.pn * tstep : cB;
        for (int t = 0; t < nt; t += 2) {
            const bool last = (t == nt - 2);
            const char* a1 = cA + (size_t)(t + 1) * kstep;
            const char* a2 = last ? nA : cA + (size_t)(t + 2) * kstep; const char* b2 = last ? nB : cB + (size_t)(t + 2) * kstep;
            const char* a3 = a2 + kstep; const char* b3 = b2 + kstep;
            if (last && has_next) S.a_ready(nxt);
            if constexpr (SP2) {
            PG8_LDB(B0, 0, 0); PG8_LDB(B1, 0, 1); PG8_SCHED; PG8_LDA(At, 0, 0); PG8_STAGE(PG8_SA(1, 1), a1 + hstepA, voffA);
            PG8_WAIT_V(8); PG8_WAIT_L(0); PG8_BAR; PG8_MMA(0, 0, At, B0); PG8_MMA(0, 1, At, B1); PG8_BAR; PG8_SCHED;
            PG8_LDA(At, 0, 1); PG8_STAGE(PG8_SB(0, 0), b2, voffB); PG8_STAGE(PG8_SB(0, 1), b2 + hstep, voffB); PG8_STAGE(PG8_SA(0, 0), a2, voffA);
            PG8_WAIT_V(8); PG8_WAIT_L(0); PG8_BAR; PG8_MMA(1, 0, At, B0); PG8_MMA(1, 1, At, B1); PG8_BAR; PG8_SCHED;
            PG8_LDB(B0, 1, 0); PG8_LDB(B1, 1, 1); PG8_SCHED; PG8_LDA(At, 1, 0); PG8_STAGE(PG8_SA(0, 1), a2 + hstepA, voffA);
            PG8_WAIT_V(8); PG8_WAIT_L(0); PG8_BAR; PG8_MMA(0, 0, At, B0); PG8_MMA(0, 1, At, B1); PG8_BAR; PG8_SCHED;
            PG8_LDA(At, 1, 1); PG8_STAGE(PG8_SB(1, 0), b3, voffB); PG8_STAGE(PG8_SB(1, 1), b3 + hstep, voffB); PG8_STAGE(PG8_SA(1, 0), a3, voffA);
            PG8_WAIT_V(8); PG8_WAIT_L(0); PG8_BAR; PG8_MMA(1, 0, At, B0); PG8_MMA(1, 1, At, B1); PG8_BAR; PG8_SCHED;
            } else {
            PG8_LDB(B0, 0, 0); PG8_SCHED; PG8_LDA(At, 0, 0); PG8_STAGE(PG8_SA(1, 1), a1 + hstepA, voffA);
            PG8_WAIT_L(8); PG8_BAR; PG8_WAIT_L(0); PG8_MMA(0, 0, At, B0); PG8_BAR; PG8_SCHED;
            PG8_LDB(B1, 0, 1); PG8_STAGE(PG8_SB(0, 0), b2, voffB);
            PG8_BAR; PG8_WAIT_L(0); PG8_MMA(0, 1, At, B1); PG8_BAR;
            PG8_LDA(At, 0, 1); PG8_STAGE(PG8_SA(0, 0), a2, voffA);
            PG8_BAR; PG8_WAIT_L(0); PG8_MMA(1, 0, At, B0); PG8_BAR; PG8_SCHED;
            PG8_STAGE(PG8_SB(0, 1), b2 + hstep, voffB);
            PG8_WAIT_V(6); PG8_BAR; PG8_MMA(1, 1, At, B1); PG8_BAR;
            PG8_LDB(B0, 1, 0); PG8_SCHED; PG8_LDA(At, 1, 0); PG8_STAGE(PG8_SA(0, 1), a2 + hstepA, voffA);
            PG8_WAIT_L(8); PG8_BAR; PG8_WAIT_L(0); PG8_MMA(0, 0, At, B0); PG8_BAR; PG8_SCHED;
            PG8_LDB(B1, 1, 1); PG8_STAGE(PG8_SB(1, 0), b3, voffB);
            PG8_BAR; PG8_WAIT_L(0); PG8_MMA(0, 1, At, B1); PG8_BAR;
            PG8_LDA(At, 1, 1); PG8_STAGE(PG8_SA(1, 0), a3, voffA);
            PG8_BAR; PG8_WAIT_L(0); PG8_MMA(1, 0, At, B0); PG8_BAR; PG8_SCHED;
            PG8_STAGE(PG8_SB(1, 1), b3 + hstep, voffB);
            PG8_WAIT_V(6); PG8_BAR; PG8_MMA(1, 1, At, B1); PG8_BAR;
            }
        }
        if constexpr (ALIGN_EPI) { if (wr == 0) PG8_BAR; }
        if constexpr (!Epi::AFTER_DRAIN) { E(acc, cur, wr, wc, fr, fq); S.done(cur); }
        if (!has_next) break;
#pragma unroll
        for (int a = 0; a < 2; ++a)
#pragma unroll
            for (int b = 0; b < 2; ++b)
#pragma unroll
                for (int m = 0; m < 4; ++m)
#pragma unroll
                    for (int n = 0; n < 2; ++n) acc[a][b][m][n] = (f32x4){0.f, 0.f, 0.f, 0.f};
        cur = nxt; cA = nA; cB = nB; ++ui;
        if constexpr (ALIGN_EPI) { if (wr == 1) PG8_BAR; }
    }
    PG8_WAIT_V(0);
    if constexpr (!ALIGN_EPI) { if (wr == 0) PG8_BAR; }
    PG8_BAR;
    if constexpr (Epi::AFTER_DRAIN) { E.fused(acc, cur, wr, wc, fr, fq, lds, wid, lane); S.done(cur); }
#undef PG8_SA
#undef PG8_SB
#undef PG8_STAGE
#undef PG8_LDA
#undef PG8_LDB
#undef PG8_MMA
#undef PG8_WAIT_V
#undef PG8_WAIT_L
#undef PG8_BAR
#undef PG8_SCHED
}
}

#define PG8_SP2 true
#define PG8_ALIGN true
namespace attn_body {
using bf16=__hip_bfloat16;
using bf16x8=__attribute__((ext_vector_type(8)))short;
using s16x4=__attribute__((ext_vector_type(4)))short;
using f32x16=__attribute__((ext_vector_type(16)))float;
using u32x4=__attribute__((ext_vector_type(4)))unsigned;
typedef float f32x4a __attribute__((ext_vector_type(4)));
constexpr int D=64;
constexpr int NW=8,QBLK=32,QB=QBLK*NW,KVBLK=64;
__device__ __forceinline__ int crow(int r,int hi){return (r&3)+8*(r>>2)+4*hi;}
#define SBAR() __builtin_amdgcn_sched_barrier(0)
constexpr int NSLOT=3, SLOTB=8192;
constexpr int LDS_K=0, LDS_V=NSLOT*SLOTB, LDS_WS=2*NSLOT*SLOTB, LDS_OST=LDS_WS+NW*64*4, LDS_BYTES=LDS_OST+NW*4096;
constexpr float C2=0.125f*1.4426950408889634f;
__device__ __forceinline__ void glds16(const void*gsrc,unsigned lds_dst){unsigned keep;
  asm volatile("s_mov_b32 %0, m0\n\ts_mov_b32 m0, %2\n\ts_nop 0\n\tglobal_load_lds_dwordx4 %1, off\n\ts_mov_b32 m0, %0":"=&s"(keep):"v"(gsrc),"s"(lds_dst):"memory");}
__device__ __forceinline__ float max3f(float a,float b,float c){float r;asm("v_max3_f32 %0, %1, %2, %3":"=v"(r):"v"(a),"v"(b),"v"(c));return r;}
__device__ __forceinline__ float max2f(float a,float b){float r;asm("v_max_f32_e32 %0, %1, %2":"=v"(r):"v"(a),"v"(b));return r;}
__device__ __forceinline__ float fadd_s(float a,float b){float r;asm("v_add_f32_e32 %0, %1, %2":"=v"(r):"v"(a),"v"(b));return r;}
__device__ __forceinline__ float fsub_s(float a,float b){float r;asm("v_sub_f32_e32 %0, %1, %2":"=v"(r):"v"(a),"v"(b));return r;}
typedef float f32x2_t __attribute__((ext_vector_type(2))); typedef __bf16 bf16x2_t __attribute__((ext_vector_type(2)));
__device__ __forceinline__ unsigned cvtpk_s(float lo,float hi){f32x2_t v={lo,hi};bf16x2_t b=__builtin_convertvector(v,bf16x2_t);return __builtin_bit_cast(unsigned,b);}
#define WAIT_BAR(N) asm volatile("s_waitcnt vmcnt(" #N ") lgkmcnt(0)\n\ts_barrier":::"memory")

__device__ __forceinline__ void qkt(f32x16&p0,f32x16&p1,const char*Kslot,const bf16x8*qr,const f32x16&negm,int r32,int hi){
  const char*kb=Kslot+hi*1024+r32*16;
  #pragma unroll
  for(int d0=0;d0<4;++d0){
    const bf16x8 b0=*reinterpret_cast<const bf16x8*>(kb+d0*2048);
    const bf16x8 b1=*reinterpret_cast<const bf16x8*>(kb+d0*2048+512);
    if(d0==0){p0=__builtin_amdgcn_mfma_f32_32x32x16_bf16(b0,qr[0],negm,0,0,0);p1=__builtin_amdgcn_mfma_f32_32x32x16_bf16(b1,qr[0],negm,0,0,0);}
    else{p0=__builtin_amdgcn_mfma_f32_32x32x16_bf16(b0,qr[d0],p0,0,0,0);p1=__builtin_amdgcn_mfma_f32_32x32x16_bf16(b1,qr[d0],p1,0,0,0);}}
}
typedef __attribute__((address_space(3))) const char* lds_cptr;
typedef short v4i16_t __attribute__((ext_vector_type(4)));
__device__ __forceinline__ void kload8(bf16x8*kf,lds_cptr kp){
  kf[0]=*(const __attribute__((address_space(3))) bf16x8*)(kp);      kf[1]=*(const __attribute__((address_space(3))) bf16x8*)(kp+512);
  kf[2]=*(const __attribute__((address_space(3))) bf16x8*)(kp+2048); kf[3]=*(const __attribute__((address_space(3))) bf16x8*)(kp+2560);
  kf[4]=*(const __attribute__((address_space(3))) bf16x8*)(kp+4096); kf[5]=*(const __attribute__((address_space(3))) bf16x8*)(kp+4608);
  kf[6]=*(const __attribute__((address_space(3))) bf16x8*)(kp+6144); kf[7]=*(const __attribute__((address_space(3))) bf16x8*)(kp+6656);
}
__device__ __forceinline__ void kload2(bf16x8*kf,lds_cptr kp,int j){ kf[2*j]=*(const __attribute__((address_space(3))) bf16x8*)(kp+j*2048); kf[2*j+1]=*(const __attribute__((address_space(3))) bf16x8*)(kp+j*2048+512); }
__device__ __forceinline__ s16x4 vtr(lds_cptr p){ return __builtin_bit_cast(s16x4,__builtin_amdgcn_ds_read_tr16_b64_v4i16((__attribute__((address_space(3))) v4i16_t*)p)); }
__device__ __forceinline__ float rowmax(const f32x16&p0,const f32x16&p1){
  float a=max3f(p0[0],p0[1],p1[0]),b=max3f(p0[2],p0[3],p1[1]);a=max3f(a,p1[2],p1[3]);
  #pragma unroll
  for(int r=4;r<16;r+=4){a=max3f(a,p0[r],p0[r+1]);b=max3f(b,p0[r+2],p0[r+3]);a=max3f(a,p1[r],p1[r+1]);b=max3f(b,p1[r+2],p1[r+3]);}
  const float m=max2f(a,b);
  auto rr=__builtin_amdgcn_permlane32_swap(__float_as_uint(m),__float_as_uint(m),false,false);
  return max2f(__uint_as_float(rr[0]),__uint_as_float(rr[1]));
}
__device__ __forceinline__ void pv(f32x16*o,int vb,bf16x8 pa0,bf16x8 pa1,bf16x8 pa2,bf16x8 pa3){
  #pragma unroll
  for(int d0=0;d0<2;++d0){s16x4 lo[4],hi[4];
    #pragma unroll
    for(int ks=0;ks<4;++ks){
      asm volatile("ds_read_b64_tr_b16 %0,%1 offset:%c2":"=&v"(lo[ks]):"v"(vb),"i"(d0*4096+ks*1024):"memory");
      asm volatile("ds_read_b64_tr_b16 %0,%1 offset:%c2":"=&v"(hi[ks]):"v"(vb),"i"(d0*4096+ks*1024+512):"memory");}
    asm volatile("s_waitcnt lgkmcnt(0)":::"memory");SBAR();
    #define PK(k) (bf16x8){lo[k][0],lo[k][1],lo[k][2],lo[k][3],hi[k][0],hi[k][1],hi[k][2],hi[k][3]}
    o[d0]=__builtin_amdgcn_mfma_f32_32x32x16_bf16(pa0,PK(0),o[d0],0,0,0);
    o[d0]=__builtin_amdgcn_mfma_f32_32x32x16_bf16(pa1,PK(1),o[d0],0,0,0);
    o[d0]=__builtin_amdgcn_mfma_f32_32x32x16_bf16(pa2,PK(2),o[d0],0,0,0);
    o[d0]=__builtin_amdgcn_mfma_f32_32x32x16_bf16(pa3,PK(3),o[d0],0,0,0);
    #undef PK
  }
}
constexpr int LDS_CS=86016;
static_assert(LDS_BYTES<=LDS_CS,"attention LDS map");
struct AttnDesc {
  const bf16*Q; const bf16*K; const bf16*V; int qstride,kstride;
  int q0,t_lo,NT,W,qadd,fox;
};
struct AttnBack {
  bf16*O; float*lse; const unsigned char*ws; int ostride,lstride,mode,mrg_off,lse_off;
};
__device__ __forceinline__ void bmask(f32x16&p0,f32x16&p1,int dq,int Wb){
  const float NEG=-INFINITY;
  #pragma unroll
  for(int r=0;r<16;++r){const int e0=dq-((r&3)+8*(r>>2)); if((unsigned)e0>(unsigned)Wb)p0[r]=NEG; if((unsigned)(e0-32)>(unsigned)Wb)p1[r]=NEG;}
}
__device__ __forceinline__ void kbias(f32x16&p0,f32x16&p1,lds_cptr cp){
  #pragma unroll
  for(int g=0;g<4;++g){
    const f32x4a a=*(const __attribute__((address_space(3))) f32x4a*)(cp+32*g), b=*(const __attribute__((address_space(3))) f32x4a*)(cp+128+32*g);
    #pragma unroll
    for(int e=0;e<4;++e){p0[4*g+e]-=a[e];p1[4*g+e]-=b[e];}}
}
#ifndef ATTN_STORE16
#define ATTN_STORE16(p,v) (*(u32x4*)(p)=(v))
#endif
template<int THRL,class BackFn> __device__ __forceinline__ void attn_unit(const AttnDesc&U,const BackFn&back,char*shm){
  const int tid=opaque_tid(),lane=tid&63,r32=lane&31,hi=lane>>5; const int wid=__builtin_amdgcn_readfirstlane(tid>>6);
  const int q0=U.q0; const long ktile=(long)KVBLK*U.kstride;
  const bf16*Qw=U.Q+(long)(q0+wid*QBLK)*U.qstride;
  const bf16*Kh=U.K+(long)U.t_lo*ktile,*Vh=U.V+(long)U.t_lo*ktile;
  const unsigned lds0=(unsigned)(uintptr_t)shm;
  float*wsf=(float*)(shm+LDS_WS)+wid*64;
  const bf16*ksrc=Kh+(long)lane*U.kstride+wid*8;
  const bf16*vsrc=Vh+(long)(16*(wid&3)+(lane>>2))*U.kstride+(wid>>2)*32+(lane&3)*8;
  const unsigned kdst=lds0+LDS_K+wid*1024, vdst=lds0+LDS_V+wid*1024;
  #define DMA_K(t,slot) glds16(ksrc+(long)(t)*ktile,(unsigned)__builtin_amdgcn_readfirstlane(kdst+(slot)))
  #define DMA_V(t,slot) glds16(vsrc+(long)(t)*ktile,(unsigned)__builtin_amdgcn_readfirstlane(vdst+(slot)))
  const int vb0=(int)(lds0+LDS_V)+((lane>>4)&1)*32+(lane&3)*8+(4*hi+((lane&15)>>2))*64;
  const char*Kbase=shm+LDS_K; bf16x8 kf[8];
  const lds_cptr shm3=(lds_cptr)shm; const lds_cptr kp0=shm3+LDS_K+hi*1024+r32*16; const lds_cptr vp0=shm3+LDS_V+((lane>>4)&1)*32+(lane&3)*8+(4*hi+((lane&15)>>2))*64;
  const int NT=U.NT;
  DMA_K(0,0);DMA_V(0,0);DMA_K(1,SLOTB);
  bf16x8 qr[4];
  #pragma unroll
  for(int d0=0;d0<4;++d0)qr[d0]=*reinterpret_cast<const bf16x8*>(&Qw[(long)r32*U.qstride+d0*16+hi*8]);
  float mhat=0.f,l_reg=0.f;f32x16 o[2];f32x16 negm; { float zf=0.f; asm volatile("":"+v"(zf)); _Pragma("unroll") for(int r=0;r<16;++r){o[0][r]=zf;o[1][r]=zf;negm[r]=zf;} } asm volatile("":"+v"(negm));
  const int qi=q0+wid*QBLK+r32+U.qadd, qlo=q0+wid*QBLK+U.qadd, Wb=U.W, foxf=U.fox; const lds_cptr csp=(lds_cptr)shm+LDS_CS;
  #define CMASK(P0,P1,t) do{ const int kl_=64*(U.t_lo+(t)); if(foxf)kbias(P0,P1,csp+4*(kl_+4*hi)); if(!((qlo-(kl_+63)>=0)&&(qlo+31-kl_<=Wb)))bmask(P0,P1,qi-kl_-4*hi,Wb); }while(0)
  bool resc=false;
  #define START(P0,P1) do{ const float rm=rowmax(P0,P1); resc=false; \
    { const float dl=(rm>-1e37f)?rm:0.f; mhat=fadd_s(mhat,dl); \
      _Pragma("unroll") for(int r=0;r<16;++r){P0[r]=fsub_s(P0[r],dl);P1[r]=fsub_s(P1[r],dl);} \
      _Pragma("unroll") for(int r=0;r<16;++r)negm[r]=-mhat; asm volatile("":"+v"(negm)); } \
    _Pragma("unroll") for(int r=0;r<16;++r)P0[r]=__builtin_amdgcn_exp2f(P0[r]); }while(0)
  #define RESC() do{ if(resc){ asm volatile("s_waitcnt lgkmcnt(0)":::"memory"); \
      _Pragma("unroll") for(int d_=0;d_<2;++d_) _Pragma("unroll") for(int r=0;r<16;++r)o[d_][r]*=wsf[crow(r,hi)]; } }while(0)
  f32x16 pA0,pA1,pB0,pB1;
  int sl_prev=0,sl_cur=0,sl_next=SLOTB;
  #define ROT() do{sl_prev=sl_cur;sl_cur=sl_next;sl_next=(sl_next==(NSLOT-1)*SLOTB)?0:sl_next+SLOTB;}while(0)
  DMA_K(2,2*SLOTB);
  WAIT_BAR(3);
  qkt(pA0,pA1,Kbase,qr,negm,r32,hi);asm volatile("s_nop 15\n\ts_nop 7":"+v"(pA0),"+v"(pA1));CMASK(pA0,pA1,0);
  START(pA0,pA1);
  _Pragma("unroll") for(int r=0;r<16;++r)pA1[r]=__builtin_amdgcn_exp2f(pA1[r]);
  WAIT_BAR(0);
  DMA_K(3,0);DMA_V(1,SLOTB);
  ROT();
  kload8(kf,kp0+sl_cur);
  WAIT_BAR(2);
  s16x4 vlo[8],vhi[8]; u32x4 pw0,pw1,pw2,pw3;
  #define PKW(P,B) cvtpk_s(P[B],P[B+1])
  #define PAF(k) __builtin_bit_cast(bf16x8,pw##k)
  #define VFR(i) (bf16x8){vlo[i][0],vlo[i][1],vlo[i][2],vlo[i][3],vhi[i][0],vhi[i][1],vhi[i][2],vhi[i][3]}
  #define PIN(x) asm volatile("":"+v"(x))
  #define MX3(a,b,c) __builtin_fmaxf(__builtin_fmaxf((a),(b)),(c))
  #define GAPA(MF,A0,A1,A2,A3,W0,W1,PW) do{ MF; sacc+=A0; sacc+=A1; sacc+=A2; sacc+=A3; PIN(sacc); W0; W1; PIN(PW); SBAR(); }while(0)
  #define EX(v) __builtin_amdgcn_exp2f(v)
  #define GAPB(MF,X,B) do{ MF; X[B]=EX(X[B]); X[B+1]=EX(X[B+1]); X[B+2]=EX(X[B+2]); X[B+3]=EX(X[B+3]); PIN(X); SBAR(); }while(0)
  #define VRD(i) do{ vlo[i]=vtr(vp_+(((i)>>2)*4096+((i)&3)*1024)); vhi[i]=vtr(vp_+(((i)>>2)*4096+((i)&3)*1024+512)); }while(0)
  #define KRD(G,j) do{ if(G){ kload2(kf,kp0+sl_next,j); SBAR(); } }while(0)
  #define STEP(C0,C1,P0,P1,t,GK,GV,GL) do{ SBAR(); \
    const lds_cptr vp_=vp0+sl_prev; \
    VRD(0); SBAR(); float sacc=(P0[0]+P0[1]); \
    GAPA(C0=__builtin_amdgcn_mfma_f32_32x32x16_bf16(kf[0],qr[0],negm,0,0,0), P0[2],P0[3],P0[4],P0[5],     pw0[0]=PKW(P0,0), pw0[1]=PKW(P0,2), pw0); \
    VRD(4); SBAR(); GAPA(C1=__builtin_amdgcn_mfma_f32_32x32x16_bf16(kf[1],qr[0],negm,0,0,0), P0[6],P0[7],P0[8],P0[9],     pw0[2]=PKW(P0,4), pw0[3]=PKW(P0,6), pw0); \
    VRD(1); SBAR(); GAPA(C0=__builtin_amdgcn_mfma_f32_32x32x16_bf16(kf[2],qr[1],C0,0,0,0),   P0[10],P0[11],P0[12],P0[13], pw1[0]=PKW(P0,8), pw1[1]=PKW(P0,10), pw1); \
    VRD(5); SBAR(); GAPA(C1=__builtin_amdgcn_mfma_f32_32x32x16_bf16(kf[3],qr[1],C1,0,0,0),   P0[14],P0[15],P1[0],P1[1],   pw1[2]=PKW(P0,12),pw1[3]=PKW(P0,14), pw1); \
    VRD(2); SBAR(); GAPA(C0=__builtin_amdgcn_mfma_f32_32x32x16_bf16(kf[4],qr[2],C0,0,0,0),   P1[2],P1[3],P1[4],P1[5],     pw2[0]=PKW(P1,0), pw2[1]=PKW(P1,2), pw2); \
    VRD(6); SBAR(); GAPA(C1=__builtin_amdgcn_mfma_f32_32x32x16_bf16(kf[5],qr[2],C1,0,0,0),   P1[6],P1[7],P1[8],P1[9],     pw2[2]=PKW(P1,4), pw2[3]=PKW(P1,6), pw2); \
    VRD(3); SBAR(); GAPA(C0=__builtin_amdgcn_mfma_f32_32x32x16_bf16(kf[6],qr[3],C0,0,0,0),   P1[10],P1[11],P1[12],P1[13], pw3[0]=PKW(P1,8), pw3[1]=PKW(P1,10), pw3); \
    VRD(7); SBAR(); GAPA(C1=__builtin_amdgcn_mfma_f32_32x32x16_bf16(kf[7],qr[3],C1,0,0,0),   P1[14],P1[15],0.f,0.f,       pw3[2]=PKW(P1,12),pw3[3]=PKW(P1,14), pw3); \
    l_reg+=sacc; \
    if(GK){DMA_K((t)+3,sl_cur);} if(GV){DMA_V((t)+1,sl_next);} \
    CMASK(C0,C1,t); \
    { float a=MX3(C0[0],C0[1],C1[0]),b=MX3(C0[2],C0[3],C1[1]); a=MX3(a,C1[2],C1[3]); \
      _Pragma("unroll") for(int r=4;r<16;r+=4){a=MX3(a,C0[r],C0[r+1]);b=MX3(b,C0[r+2],C0[r+3]);a=MX3(a,C1[r],C1[r+1]);b=MX3(b,C1[r+2],C1[r+3]);} \
      float rm=__builtin_fmaxf(a,b); { auto rr=__builtin_amdgcn_permlane32_swap(__float_as_uint(rm),__float_as_uint(rm),false,false); rm=__builtin_fmaxf(__uint_as_float(rr[0]),__uint_as_float(rr[1])); } \
      resc=false; \
      if(__builtin_expect(__any(rm>(float)THRL),0)){ const float dl=__builtin_fmaxf(rm,0.f); mhat+=dl; \
        _Pragma("unroll") for(int r=0;r<16;++r){C0[r]-=dl;C1[r]-=dl;} \
        _Pragma("unroll") for(int r=0;r<16;++r)negm[r]=-mhat; asm volatile("":"+v"(negm)); \
        const float f=__builtin_amdgcn_exp2f(-dl); l_reg*=f; if(hi==0)wsf[r32]=f; resc=true; } } \
    SBAR(); \
    GAPB(o[0]=__builtin_amdgcn_mfma_f32_32x32x16_bf16(PAF(0),VFR(0),o[0],0,0,0), C0,0); \
    GAPB(o[1]=__builtin_amdgcn_mfma_f32_32x32x16_bf16(PAF(0),VFR(4),o[1],0,0,0), C0,4); \
    KRD(GL,0); GAPB(o[0]=__builtin_amdgcn_mfma_f32_32x32x16_bf16(PAF(1),VFR(1),o[0],0,0,0), C0,8); \
    KRD(GL,1); GAPB(o[1]=__builtin_amdgcn_mfma_f32_32x32x16_bf16(PAF(1),VFR(5),o[1],0,0,0), C0,12); \
    KRD(GL,2); GAPB(o[0]=__builtin_amdgcn_mfma_f32_32x32x16_bf16(PAF(2),VFR(2),o[0],0,0,0), C1,0); \
    KRD(GL,3); GAPB(o[1]=__builtin_amdgcn_mfma_f32_32x32x16_bf16(PAF(2),VFR(6),o[1],0,0,0), C1,4); \
    GAPB(o[0]=__builtin_amdgcn_mfma_f32_32x32x16_bf16(PAF(3),VFR(3),o[0],0,0,0), C1,8); \
    GAPB(o[1]=__builtin_amdgcn_mfma_f32_32x32x16_bf16(PAF(3),VFR(7),o[1],0,0,0), C1,12); \
    }while(0)
  int t=1;
  for(;t+5<NT;t+=2){
    STEP(pB0,pB1,pA0,pA1,t,true,true,true);     WAIT_BAR(2); RESC(); ROT();
    STEP(pA0,pA1,pB0,pB1,t+1,true,true,true);   WAIT_BAR(2); RESC(); ROT();
  }
  #define ENDW(tt) do{ if((tt)+3<NT){WAIT_BAR(2);} else if((tt)+2<NT){WAIT_BAR(1);} else {WAIT_BAR(0);} }while(0)
  for(;t+1<NT;t+=2){
    STEP(pB0,pB1,pA0,pA1,t,(t+3<NT),(t+1<NT),(t+1<NT));       ENDW(t);   RESC(); ROT();
    STEP(pA0,pA1,pB0,pB1,t+1,(t+4<NT),(t+2<NT),(t+2<NT));     ENDW(t+1); RESC(); ROT();
  }
  STEP(pB0,pB1,pA0,pA1,NT-1,false,false,false); RESC();
  { float sacc=pB0[0]+pB0[1]; _Pragma("unroll") for(int r=2;r<16;++r)sacc+=pB0[r]; _Pragma("unroll") for(int r=0;r<16;++r)sacc+=pB1[r]; l_reg+=sacc;
    pw0=(u32x4){PKW(pB0,0),PKW(pB0,2),PKW(pB0,4),PKW(pB0,6)};pw1=(u32x4){PKW(pB0,8),PKW(pB0,10),PKW(pB0,12),PKW(pB0,14)};pw2=(u32x4){PKW(pB1,0),PKW(pB1,2),PKW(pB1,4),PKW(pB1,6)};pw3=(u32x4){PKW(pB1,8),PKW(pB1,10),PKW(pB1,12),PKW(pB1,14)};
    SBAR(); pv(o,vb0+sl_cur,PAF(0),PAF(1),PAF(2),PAF(3)); }
  #undef PKW
  #undef PAF
  #undef VFR
  #undef PIN
  #undef MX3
  #undef GAPA
  #undef GAPB
  #undef EX
  #undef VRD
  #undef KRD
  #undef STEP
  #undef ENDW
  {auto rr=__builtin_amdgcn_permlane32_swap(__float_as_uint(l_reg),__float_as_uint(l_reg),false,false);l_reg=__uint_as_float(rr[0])+__uint_as_float(rr[1]);}
  const float lse_own=mhat+__log2f(l_reg);
  const AttnBack B=back();
  if(hi==0){wsf[32+r32]=l_reg;wsf[r32]=lse_own;}
  asm volatile("s_waitcnt lgkmcnt(0)":::"memory");
  if(B.mode==1&&hi==0)B.lse[(long)(q0+wid*QBLK+r32)*B.lstride]=lse_own;
  float rli[16];
  #pragma unroll
  for(int r=0;r<16;++r)rli[r]=__builtin_amdgcn_rcpf(wsf[32+crow(r,hi)]);
  bf16*Ow=B.O+(long)(q0+wid*QBLK)*B.ostride;
  { bf16*stg=(bf16*)(shm+LDS_OST)+wid*2048;
    #pragma unroll
    for(int r=0;r<16;++r){const int orow=crow(r,hi);
      #pragma unroll
      for(int d0=0;d0<2;++d0)stg[orow*64+d0*32+r32]=__float2bfloat16(o[d0][r]*rli[r]);}
    asm volatile("s_waitcnt lgkmcnt(0)":::"memory");
    #pragma unroll
    for(int i=0;i<4;++i){const int row=i*8+(lane>>3),ch=lane&7; u32x4 v=*(const u32x4*)(stg+row*64+ch*8);
      if(B.mode==2){ const int pos=q0+wid*QBLK+row; const float l1=wsf[row],l4=((const float*)(B.ws+WS_LSE4))[B.lse_off+pos],l16=((const float*)(B.ws+WS_LSE16))[B.lse_off+pos];
        const float mx=fmaxf(l1,fmaxf(l4,l16)); float w1=__builtin_amdgcn_exp2f(l1-mx),w4=__builtin_amdgcn_exp2f(l4-mx),w16=__builtin_amdgcn_exp2f(l16-mx);
        const float inv=1.0f/(w1+w4+w16); w1*=inv; w4*=inv; w16*=inv;
        const u32x4 a4=*(const u32x4*)((const bf16*)(B.ws+WS_OB4)+B.mrg_off+(long)pos*768+ch*8), a16=*(const u32x4*)((const bf16*)(B.ws+WS_OB16)+B.mrg_off+(long)pos*768+ch*8);
        #pragma unroll
        for(int e=0;e<4;++e){
          const float lo=w1*__uint_as_float(v[e]<<16)+w4*__uint_as_float(a4[e]<<16)+w16*__uint_as_float(a16[e]<<16);
          const float hh=w1*__uint_as_float(v[e]&0xffff0000u)+w4*__uint_as_float(a4[e]&0xffff0000u)+w16*__uint_as_float(a16[e]&0xffff0000u);
          v[e]=cvtpk_s(lo,hh);} }
      ATTN_STORE16(Ow+(long)row*B.ostride+ch*8,v);} }
  asm volatile("s_waitcnt lgkmcnt(0)\n\ts_barrier":::"memory");
  #undef DMA_K
  #undef DMA_V
  #undef CMASK
  #undef START
  #undef RESC
  #undef ROT
}
__device__ __forceinline__ void fox_scan(const float*fl,char*shm){
  const int tid=opaque_tid(),lane=tid&63,wid=tid>>6;
  const f32x4a a=((const f32x4a*)fl)[2*tid],b=((const f32x4a*)fl)[2*tid+1];
  float v[8]={a[0],a[1],a[2],a[3],b[0],b[1],b[2],b[3]};
  #pragma unroll
  for(int i=1;i<8;++i)v[i]+=v[i-1];
  float incl=v[7];
  #pragma unroll
  for(int o=1;o<64;o<<=1){const float t=__shfl_up(incl,o);if(lane>=o)incl+=t;}
  const float excl=incl-v[7];
  float*wt=(float*)(shm+LDS_CS+16384);
  if(lane==63)wt[wid]=incl;
  __syncthreads();
  float base=excl;
  for(int w=0;w<wid;++w)base+=wt[w];
  const float L2E=1.4426950408889634f;
  f32x4a o0,o1;
  #pragma unroll
  for(int i=0;i<4;++i){o0[i]=(base+v[i])*L2E;o1[i]=(base+v[4+i])*L2E;}
  f32x4a*cs=(f32x4a*)(shm+LDS_CS);
  cs[2*tid]=o0;cs[2*tid+1]=o1;
  __syncthreads();
}
#undef SBAR
#undef WAIT_BAR
}

constexpr int LDSCTL_OFF = 0, LDSCTL_BYTES = 2048, MISC_OFF = LDSCTL_OFF + 320;
constexpr int RING_OFF = LDSCTL_BYTES, RING_BYTES = 131072;
constexpr int LDS_BYTES = 147456;
static_assert(attn_body::LDS_CS + 16384 + 64 <= RING_BYTES && RING_OFF + RING_BYTES <= LDS_BYTES, "LDS map");

#define GAS __attribute__((address_space(1)))
#define LAS __attribute__((address_space(3)))
typedef unsigned short bf16;
typedef unsigned v4u __attribute__((ext_vector_type(4)));
typedef float f32x4 __attribute__((ext_vector_type(4)));
typedef short bf16x8 __attribute__((ext_vector_type(8)));
typedef GAS unsigned gu32;
typedef GAS unsigned long long gu64;
#define RLX_AGENT __ATOMIC_RELAXED, __HIP_MEMORY_SCOPE_AGENT
#define LDS_WAIT() asm volatile("s_waitcnt lgkmcnt(0)" ::: "memory")
#define VM_WAIT() asm volatile("s_waitcnt vmcnt(0)" ::: "memory")
__device__ __forceinline__ unsigned long long rt() { return __builtin_amdgcn_s_memrealtime(); }
__device__ __forceinline__ unsigned f2bf(float f) { unsigned u = __builtin_bit_cast(unsigned, f); return (u + 0x7fffu + ((u >> 16) & 1u)) >> 16; }
__device__ __forceinline__ unsigned pk2(float lo, float hi) { return f2bf(lo) | (f2bf(hi) << 16); }

#define XB_TMO      128
#define XB_XCNT(j)  (256  + 64 * (j))
#define XB_XSUB(j)  (1280 + 64 * (j))
#define XB_XGEN(j)  (2304 + 64 * (j))
#define XB_TOP      3328
#define XB_TOPGEN   3392
#define XCD_BAR_WORDS 3456
#define XB_SPIN_CAP (1u << 18)

__device__ __forceinline__ unsigned xb_ld(unsigned* p)              { return __hip_atomic_load(p, __ATOMIC_RELAXED, __HIP_MEMORY_SCOPE_AGENT); }
__device__ __forceinline__ unsigned xb_add(unsigned* p, unsigned v) { return __hip_atomic_fetch_add(p, v, __ATOMIC_RELAXED, __HIP_MEMORY_SCOPE_AGENT); }
__device__ __forceinline__ unsigned xb_xcc_id() { return (unsigned)__builtin_amdgcn_s_getreg((3 << 11) | 20) & 0xFu; }
#define XB_SPIN(cond, bar) do { unsigned _sp = 0; while (cond) { __builtin_amdgcn_s_sleep(1); \
    if ((++_sp & 255u) == 0u) { if (xb_ld(&(bar)[XB_TMO])) break; if (_sp > XB_SPIN_CAP) { atomicAdd(&(bar)[XB_TMO], 1u); break; } } } } while (0)

struct XcdBarrier {
    unsigned* bar; unsigned x;
    volatile LAS unsigned* st;
};

__device__ __forceinline__ XcdBarrier xcd_barrier_post(unsigned* bar, volatile LAS unsigned* st) {
    XcdBarrier b; b.bar = bar; b.x = xb_xcc_id(); b.st = st;
    if (threadIdx.x == 0) (void)xb_add(&bar[XB_XCNT(b.x)], 1u);
    return b;
}
__device__ __forceinline__ void xcd_barrier_complete(unsigned* bar, unsigned x, unsigned& nloc, unsigned& nx) {
    const unsigned G = gridDim.x * gridDim.y * gridDim.z;
    unsigned sum, cnt, mine, sp = 0u;
    for (;;) {
        sum = 0u; cnt = 0u; mine = 0u;
#pragma unroll
        for (unsigned j = 0; j < 16; ++j) { const unsigned c = xb_ld(&bar[XB_XCNT(j)]); sum += c; cnt += (c > 0u) ? 1u : 0u; mine = (j == x) ? c : mine; }
        if (sum == G) break;
        __builtin_amdgcn_s_sleep(1);
        if ((++sp & 255u) == 0u) { if (xb_ld(&bar[XB_TMO])) break; if (sp > XB_SPIN_CAP) { atomicAdd(&bar[XB_TMO], 1u); break; } }
    }
    nloc = mine > 0u ? mine : 1u; nx = cnt > 0u ? cnt : 1u;
}

__device__ __forceinline__ void xcd_barrier(const XcdBarrier& b) {
    asm volatile("s_waitcnt vmcnt(0)" ::: "memory");
    __syncthreads();
    if (threadIdx.x == 0) {
        unsigned* bar = b.bar;
        __builtin_amdgcn_s_waitcnt(0);
        unsigned nloc = b.st[0], nx = b.st[1];
        if (nloc == 0u) { xcd_barrier_complete(bar, b.x, nloc, nx); b.st[0] = nloc; b.st[1] = nx; }
        const unsigned old = xb_add(&bar[XB_XSUB(b.x)], 1u);
        const unsigned gen = old / nloc;
        if (old + 1u == (gen + 1u) * nloc) {
            __builtin_amdgcn_fence(__ATOMIC_RELEASE, "agent");
            asm volatile("s_waitcnt vmcnt(0)" ::: "memory");
            const unsigned og = xb_add(&bar[XB_TOP], 1u);
            const unsigned tg = og / nx;
            if (og + 1u == (tg + 1u) * nx) xb_add(&bar[XB_TOPGEN], 1u);
            else XB_SPIN(xb_ld(&bar[XB_TOPGEN]) == tg, bar);
            __builtin_amdgcn_fence(__ATOMIC_ACQUIRE, "agent");
            xb_add(&bar[XB_XGEN(b.x)], 1u);
            asm volatile("s_waitcnt vmcnt(0)" ::: "memory");
        } else {
            XB_SPIN(xb_ld(&bar[XB_XGEN(b.x)]) == gen, bar);
            __builtin_amdgcn_fence(__ATOMIC_ACQUIRE, "agent");
            asm volatile("s_waitcnt vmcnt(0)" ::: "memory");
        }
    }
    __syncthreads();
}

struct Frame {
    LAS unsigned char* lds;
    volatile LAS unsigned* MISC;
    gu32* ctl;
    int tid, lane, wave, vcu;
};
__device__ __forceinline__ void frame_refresh(Frame& F, unsigned char* ldsarr) {
    F.lds = (LAS unsigned char*)ldsarr + opaque_zero(); F.tid = opaque_tid(); F.lane = F.tid & 63; F.wave = __builtin_amdgcn_readfirstlane(F.tid >> 6);
}
__device__ __forceinline__ float wave_sum(float v) {
#pragma unroll
    for (int o = 1; o < 64; o <<= 1) v += __shfl_xor(v, o);
    return v;
}
enum { CM_ID = 0, CM_FOX = 1, CM_DIL = 2, CM_UP = 3 };
__device__ __forceinline__ int rope_perm(int j) { return (j & 1) ? 32 + (j >> 1) : (j >> 1); }
__device__ __forceinline__ int colmap(int kind, int n) {
    if (kind == CM_ID) return n;
    if (kind == CM_UP) { const int pn = n >> 8, bj = (n >> 7) & 1, j = n & 127; return bj * FFD + 128 * pn + j; }
    if (kind == CM_FOX) { if (n < 768) return n; if (n < 1024) return 2316 + (n - 768); if (n < 1792) return 768 + (n - 1024); if (n < 2560) return 1536 + (n - 1792); if (n < 2572) return 2304 + (n - 2560); return -1; }
    if (n < 768) return (n & ~63) + rope_perm(n & 63);
    if (n < 1024) return 2304 + (n - 768);
    if (n < 1792) { const int k = n - 1024; return 768 + (k & ~63) + rope_perm(k & 63); }
    return 1536 + (n - 1792);
}
__device__ __forceinline__ f32x4 conv_load4(const float* wrow, int kind, int n4) {
    if (kind == CM_DIL && n4 < 1792 && !(n4 >= 768 && n4 < 1024)) {
        const int k = n4 < 768 ? n4 : n4 - 1024, hb = (n4 < 768 ? 0 : 768) + (k & ~63), m2 = (k & 63) >> 1;
        typedef float f32x2 __attribute__((ext_vector_type(2)));
        const f32x2 a = *(const GAS f32x2*)(wrow + hb + m2), b = *(const GAS f32x2*)(wrow + hb + 32 + m2);
        return (f32x4){a.x, b.x, a.y, b.y};
    }
    const int sc = colmap(kind, n4);
    if (sc < 0) return (f32x4){0.f, 0.f, 0.f, 0.f};
    return *(const GAS f32x4*)(wrow + sc);
}
__device__ __forceinline__ void transpose_item(const float* W, int K, int Nsrc, bf16* WT, const float* g, int kind, int kb, int nb, int lane) {
    const int kg = lane & 7, ng = lane >> 3, k0 = 64 * kb + 8 * kg, n4 = 32 * nb + 4 * ng;
    f32x4 v[8];
#pragma unroll
    for (int j = 0; j < 8; ++j) v[j] = conv_load4(W + (size_t)(k0 + j) * Nsrc, kind, n4);
    if (g) { const f32x4 g0 = *(const GAS f32x4*)(g + k0), g1 = *(const GAS f32x4*)(g + k0 + 4);
        v[0] = v[0] * g0.x; v[1] = v[1] * g0.y; v[2] = v[2] * g0.z; v[3] = v[3] * g0.w; v[4] = v[4] * g1.x; v[5] = v[5] * g1.y; v[6] = v[6] * g1.z; v[7] = v[7] * g1.w; }
#pragma unroll
    for (int e = 0; e < 4; ++e) { v4u o; o.x = pk2(v[0][e], v[1][e]); o.y = pk2(v[2][e], v[3][e]); o.z = pk2(v[4][e], v[5][e]); o.w = pk2(v[6][e], v[7][e]);
        *(GAS v4u*)(WT + (size_t)(n4 + e) * K + k0) = o; }
}
__device__ __forceinline__ void convert_matrix(Frame& F, const float* W, int K, int Nsrc, bf16* WT, int Ndst, const float* g, int kind) {
    const int gw = F.vcu * NWAVES + F.wave, NGW = GRID * NWAVES, nblk = Ndst / 32, nitems = (K / 64) * nblk;
    for (int it = gw; it < nitems; it += NGW) transpose_item(W, K, Nsrc, WT, g, kind, it / nblk, it % nblk, F.lane);
}

constexpr int PT_OFF = LDSCTL_OFF + 1024;   static_assert(PT_OFF + 17 * 8 <= LDSCTL_BYTES && MISC_OFF + 128 <= PT_OFF, "LDS control map");
enum { PT_X = 0, PT_MEM, PT_NMIX, PT_NMEM, PT_NFFN, PT_WFOX, PT_BFOR, PT_WDIL, PT_WMKV, PT_WOUT, PT_WUP, PT_CW, PT_CB, PT_WDN, PT_NFIN, PT_OUT, PT_WS };
__device__ __forceinline__ GAS unsigned char* ldptr(LAS unsigned char* lds, int i) {
    volatile LAS unsigned* p = (volatile LAS unsigned*)(lds + PT_OFF) + 2 * i;
    const unsigned lo = __builtin_amdgcn_readfirstlane(p[0]), hi = __builtin_amdgcn_readfirstlane(p[1]);
    return (GAS unsigned char*)(((unsigned long long)hi << 32) | lo);
}
#define PTR_F(i) ((const float*)(unsigned char*)ldptr(F.lds, (i)))
struct UnitKey { int kind, i, layer, v; };
__device__ __forceinline__ void attn_make(const UnitKey& key, const unsigned char* ws, attn_body::AttnDesc& U, attn_body::AttnBack& B, int& bh) {
    typedef attn_body::bf16 abf;
    const int kind = key.kind, i = key.i, layer = key.layer, v = key.v;
    bh = 0;
    U.fox = 0; U.qadd = 0; U.W = 128; U.t_lo = 0; U.NT = 4; U.q0 = 0;
    B.ws = ws; B.mode = 0; B.lse = nullptr; B.lstride = 0; B.mrg_off = 0; B.lse_off = 0;
    const abf* QOa = (const abf*)(ws + WS_QO); const abf* KBa = (const abf*)(ws + WS_K); const abf* VBa = (const abf*)(ws + WS_V);
    if ((kind != 1) && i == 3) {
        const int b = v >> 6, hm = (v >> 4) & 3, qb = v & 15;
        U.Q = QOa + (size_t)(b * SEQ) * 1024 + (12 + hm) * 64; B.O = (abf*)U.Q; U.qstride = 1024; B.ostride = 1024;
        U.K = (const abf*)(ws + WS_KVM) + (size_t)(b * MEMT) * 2048 + 512 * layer + 64 * hm; U.V = U.K + 256; U.kstride = 2048;
        U.q0 = 256 * qb; U.W = 0x7fffffff; U.qadd = 1 << 20;
    } else if (kind == 0) {
        const int g = v >> 4, ii = v & 15; bh = 3 * g + i; const int qb = i == 0 ? ii : (i == 1 ? ((ii + 8) & 15) : (ii < 8 ? 15 - 2 * ii : 30 - 2 * ii));
        const int b = bh / NMIX, h = bh % NMIX;
        U.Q = QOa + (size_t)(b * SEQ) * 1024 + h * 64; B.O = (abf*)U.Q; U.qstride = 1024; B.ostride = 1024;
        U.K = KBa + (size_t)(b * SEQ) * 768 + h * 64; U.V = VBa + (size_t)(b * SEQ) * 768 + h * 64; U.kstride = 768;
        U.q0 = 256 * qb; U.NT = 4 * qb + 4; U.W = 0x7fffffff; U.fox = 1;
    } else if (kind == 1 && i < 3) {
        const int e = v + 256 * i, r = e & 15; bh = e >> 4; const int b = bh / NMIX, h = bh % NMIX;
        U.Q = QOa + (size_t)(b * SEQ + r) * 1024 + h * 64; U.qstride = 16 * 1024;
        B.O = (abf*)(ws + WS_OB16) + (size_t)(b * SEQ + r) * 768 + h * 64; B.ostride = 16 * 768;
        U.K = KBa + (size_t)(b * SEQ + r) * 768 + h * 64; U.V = VBa + (size_t)(b * SEQ + r) * 768 + h * 64; U.kstride = 16 * 768;
        B.mode = 1; B.lse = (float*)(ws + WS_LSE16) + (size_t)bh * SEQ + r; B.lstride = 16;
    } else if (kind == 1) {
        const int k = i - 3, e = v + 256 * k, qb = ((v & 3) + k) & 3, rest = e >> 2, r = rest & 3; bh = rest >> 2; const int b = bh / NMIX, h = bh % NMIX;
        U.Q = QOa + (size_t)(b * SEQ + r) * 1024 + h * 64; U.qstride = 4 * 1024;
        B.O = (abf*)(ws + WS_OB4) + (size_t)(b * SEQ + r) * 768 + h * 64; B.ostride = 4 * 768;
        U.K = KBa + (size_t)(b * SEQ + r) * 768 + h * 64; U.V = VBa + (size_t)(b * SEQ + r) * 768 + h * 64; U.kstride = 4 * 768;
        U.q0 = 256 * qb; U.t_lo = qb ? 4 * qb - 2 : 0; U.NT = qb ? 6 : 4;
        B.mode = 1; B.lse = (float*)(ws + WS_LSE4) + (size_t)bh * SEQ + r; B.lstride = 4;
    } else {
        const int e = v + 256 * i, qb = e & 15; bh = e >> 4; const int b = bh / NMIX, h = bh % NMIX;
        U.Q = QOa + (size_t)(b * SEQ) * 1024 + h * 64; B.O = (abf*)U.Q; U.qstride = 1024; B.ostride = 1024;
        U.K = KBa + (size_t)(b * SEQ) * 768 + h * 64; U.V = VBa + (size_t)(b * SEQ) * 768 + h * 64; U.kstride = 768;
        U.q0 = 256 * qb; U.t_lo = qb ? 4 * qb - 2 : 0; U.NT = qb ? 6 : 4;
        B.mode = 2; B.mrg_off = (b * SEQ) * 768 + h * 64; B.lse_off = bh * SEQ;
    }
}
struct AttnBackFn { UnitKey key; LAS unsigned char* lds;
    __device__ __forceinline__ attn_body::AttnBack operator()() const { attn_body::AttnDesc U; attn_body::AttnBack B; int bh; attn_make(key, (const unsigned char*)ldptr(lds, PT_WS), U, B, bh); return B; }
};
struct Args { const float* in[15]; float* out; unsigned char* ws; };
__global__ void __launch_bounds__(NWAVES * 64, 2) mk_fwd(Args args) {
    extern __shared__ __attribute__((aligned(16))) unsigned char lds[];
    Frame F;
    F.lds = (LAS unsigned char*)lds;
    F.MISC = (volatile LAS unsigned*)(F.lds + MISC_OFF);
    F.tid = threadIdx.x; F.lane = F.tid & 63; F.wave = __builtin_amdgcn_readfirstlane(F.tid >> 6);
    { const int bx = blockIdx.x; F.vcu = (bx % 8) * (GRID / 8) + bx / 8; }
    F.ctl = (gu32*)(args.ws + WS_CTL);
    for (int u = F.tid; u < LDSCTL_BYTES / 4; u += NWAVES * 64) ((LAS unsigned*)(F.lds + LDSCTL_OFF))[u] = 0u;
    __syncthreads();
    if (F.tid == 0) { LAS unsigned long long* pt = (LAS unsigned long long*)(F.lds + PT_OFF);
#pragma unroll
        for (int i = 0; i < 15; ++i) pt[i] = (unsigned long long)args.in[i];
        pt[PT_OUT] = (unsigned long long)args.out; pt[PT_WS] = (unsigned long long)args.ws; }
    __syncthreads();
    XcdBarrier bar = xcd_barrier_post((unsigned*)(F.ctl + CW_BAR), F.MISC + 8);
#define GRID_BAR() do { XcdBarrier b_ = bar; b_.bar += opaque_zero(); b_.x += (unsigned)opaque_zero(); xcd_barrier(b_); } while (0)

#ifdef PROBE
    int n_stamp = 0;
#define STAMP() do { if (blockIdx.x == 0 && threadIdx.x == 0) ((GAS unsigned long long*)(bar.bar - CW_BAR + 131072))[n_stamp] = __builtin_amdgcn_s_memrealtime(); ++n_stamp; } while (0)
#else
#define STAMP() do {} while (0)
#endif
#ifdef PROBE
#define STAMP2(k) do { if (blockIdx.x == 0 && threadIdx.x == 0) ((GAS unsigned long long*)(bar.bar - CW_BAR + 131072))[k] = __builtin_amdgcn_s_memrealtime(); } while (0)
#else
#define STAMP2(k) do {} while (0)
#endif
    STAMP();
    {
        frame_refresh(F, lds); unsigned char* ws = (unsigned char*)ldptr(F.lds, PT_WS);
        const int gw = F.vcu * NWAVES + F.wave, NGW = GRID * NWAVES, gtid = F.vcu * (NWAVES * 64) + F.tid, NGT = GRID * NWAVES * 64;
#pragma nounroll
        for (int l = 0; l < DEPTH; ++l) {
            bf16* win = (bf16*)(ws + WS_WIN + (size_t)l * WIN_STRIDE);
            if (l & 1) convert_matrix(F, PTR_F(PT_WDIL) + (size_t)(l >> 1) * DMODEL * DIL_IN, DMODEL, DIL_IN, win, 2560, PTR_F(PT_NMIX) + l * DMODEL, CM_DIL);
            else convert_matrix(F, PTR_F(PT_WFOX) + (size_t)(l >> 1) * DMODEL * FOX_IN, DMODEL, FOX_IN, win, 2816, PTR_F(PT_NMIX) + l * DMODEL, CM_FOX);
            convert_matrix(F, PTR_F(PT_WOUT) + (size_t)l * DMODEL * DMODEL, DMODEL, DMODEL, (bf16*)(ws + WS_WOUT + (size_t)l * WOUT_STRIDE), 1024, nullptr, CM_ID);
            convert_matrix(F, PTR_F(PT_WMKV) + (size_t)l * DMODEL * 512, DMODEL, 512, (bf16*)(ws + WS_WMKV) + (size_t)l * 512 * DMODEL, 512, PTR_F(PT_NMEM) + l * DMODEL, CM_ID);
        }
        STAMP2(101);
        {
            const float* x = PTR_F(PT_X); float* hres = (float*)(unsigned char*)ldptr(F.lds, PT_OUT); bf16* hb = (bf16*)(ws + WS_HB); float* ssqA = (float*)(ws + WS_SSQA);
            for (int m = gw; m < MTOK; m += NGW) {
                const GAS f32x4* xr = (const GAS f32x4*)(x + (size_t)m * DMODEL) + F.lane; GAS f32x4* hr = (GAS f32x4*)(hres + (size_t)m * DMODEL) + F.lane;
                GAS unsigned long long* o8 = (GAS unsigned long long*)(hb + (size_t)(m + 2) * DMODEL) + F.lane;
                float s = 0.f;
#pragma unroll
                for (int j = 0; j < 4; ++j) { const f32x4 v = xr[64 * j]; s += (v.x * v.x + v.y * v.y) + (v.z * v.z + v.w * v.w); hr[64 * j] = v;
                    o8[64 * j] = (unsigned long long)pk2(v.x, v.y) | ((unsigned long long)pk2(v.z, v.w) << 32); }
                s = wave_sum(s);
                if (F.lane == 0) { ssqA[m] = s; ssqA[MTOK + m] = 0.f; ssqA[2 * MTOK + m] = 0.f; ssqA[3 * MTOK + m] = 0.f; }
            }
            for (int idx = gtid; idx < 258 * 128; idx += NGT) { const int r = idx >> 7, c = idx & 127; const int row = r < 2 ? r : MTOK + r; *(GAS v4u*)(hb + (size_t)row * DMODEL + c * 8) = (v4u){0u, 0u, 0u, 0u}; }
        }
        STAMP2(102);
        {
            const float* mem = PTR_F(PT_MEM); bf16* memb = (bf16*)(ws + WS_MEMB); float* rmem = (float*)(ws + WS_RMEM);
            for (int m = gw; m < BATCH * MEMT; m += NGW) {
                const GAS f32x4* xr = (const GAS f32x4*)(mem + (size_t)m * DMODEL) + F.lane; GAS unsigned long long* o8 = (GAS unsigned long long*)(memb + (size_t)m * DMODEL) + F.lane;
                float s = 0.f;
#pragma unroll
                for (int j = 0; j < 4; ++j) { const f32x4 v = xr[64 * j]; s += (v.x * v.x + v.y * v.y) + (v.z * v.z + v.w * v.w);
                    o8[64 * j] = (unsigned long long)pk2(v.x, v.y) | ((unsigned long long)pk2(v.z, v.w) << 32); }
                s = wave_sum(s);
                if (F.lane == 0) rmem[m] = 1.0f / sqrtf(s * (1.0f / DMODEL) + 1e-6f);
            }
        }
        STAMP2(103);
        {
            float* rope = (float*)(ws + WS_ROPE);
            for (int idx = gtid; idx < SEQ * 32; idx += NGT) { const int pos = idx >> 5, i = idx & 31;
                const float inv = (float)exp(-(double)(2 * i) / 64.0 * 9.210340371976184); const float ang = (float)pos * inv; float sn, cs; sincosf(ang, &sn, &cs);
                rope[idx] = cs; rope[SEQ * 32 + idx] = sn; }
        }
    }
    STAMP2(104);
    GRID_BAR(); STAMP();

#pragma nounroll
    for (int layer = 0; layer < DEPTH; ++layer) {
        const int dil = layer & 1, slot = layer >> 1;
        {
            frame_refresh(F, lds); unsigned char* ws = (unsigned char*)ldptr(F.lds, PT_WS);
            pg8::Gemm g{(const pg8::bf16_t*)(ws + WS_HB) + 2 * DMODEL, (const pg8::bf16_t*)(ws + WS_WIN + (size_t)layer * WIN_STRIDE), DMODEL, 0};
            pg8::StaticOrder S; S.init(64, dil ? 10 : 11, GRID, (int)blockIdx.x);
            pg8::EpiInProj E{(pg8::bf16_t*)(ws + WS_QO), (pg8::bf16_t*)(ws + WS_K), (pg8::bf16_t*)(ws + WS_V), (float*)(ws + WS_FLOG), (const float*)(ws + WS_SSQA), PTR_F(PT_BFOR) + slot * NMIX, (const float*)(ws + WS_ROPE), dil};
#ifndef NO_INPROJ
            pg8::gemm_phase<pg8::EpiInProj, pg8::StaticOrder, PG8_ALIGN, PG8_SP2>(F.lds + RING_OFF, g, S, E);
#endif
        }
        if (layer == 0) {
            frame_refresh(F, lds); unsigned char* ws = (unsigned char*)ldptr(F.lds, PT_WS);
            pg8::Gemm g2{(const pg8::bf16_t*)(ws + WS_MEMB), (const pg8::bf16_t*)(ws + WS_WMKV), DMODEL, 0};
            pg8::StaticOrder S2; S2.init(4, 8, GRID, ((int)blockIdx.x + 64) & 255);
            pg8::EpiMemKV E2{(pg8::bf16_t*)(ws + WS_KVM), (const float*)(ws + WS_RMEM)};
#ifndef NO_MEMKV
            pg8::gemm_phase<pg8::EpiMemKV, pg8::StaticOrder, PG8_ALIGN, PG8_SP2>(F.lds + RING_OFF, g2, S2, E2);
#endif
        }
        GRID_BAR(); STAMP();
        {
            frame_refresh(F, lds); unsigned char* ws = (unsigned char*)ldptr(F.lds, PT_WS);
            convert_matrix(F, PTR_F(PT_WUP) + (size_t)layer * DMODEL * FF2, DMODEL, FF2, (bf16*)(ws + WS_WUP), FF2, PTR_F(PT_NFFN) + layer * DMODEL, CM_UP);
            convert_matrix(F, PTR_F(PT_WDN) + (size_t)layer * FFD * DMODEL, FFD, DMODEL, (bf16*)(ws + WS_WDN), DMODEL, nullptr, CM_ID);
        }
        __syncthreads();
        if (layer < 2) STAMP2(110 + 20 * layer);
#pragma nounroll
        for (int sub = 0; sub < 1 + dil; ++sub) {
            const int kind = dil ? 1 + sub : 0;
            const int nun = kind == 1 ? 6 : 4;
#pragma nounroll
            for (int i = 0; i < nun; ++i) {
                frame_refresh(F, lds);
                const UnitKey key{kind, i, layer, F.vcu};
                attn_body::AttnDesc U; attn_body::AttnBack Bdummy; int bh = 0;
                { const unsigned char* ws = (unsigned char*)ldptr(F.lds, PT_WS); attn_make(key, ws, U, Bdummy, bh);
                  if (U.fox) attn_body::fox_scan((const float*)(ws + WS_FLOG) + (size_t)bh * SEQ, (char*)F.lds + RING_OFF); }
#ifndef NO_ATTN
                        attn_body::attn_unit<8>(U, AttnBackFn{key, F.lds}, (char*)F.lds + RING_OFF);
#endif
                if (layer < 2) STAMP2(111 + 20 * layer + 8 * sub + i);
            }
            GRID_BAR(); STAMP();
        }
        {
            frame_refresh(F, lds); unsigned char* ws = (unsigned char*)ldptr(F.lds, PT_WS);
            pg8::Gemm g{(const pg8::bf16_t*)(ws + WS_QO), (const pg8::bf16_t*)(ws + WS_WOUT + (size_t)layer * WOUT_STRIDE), DMODEL, 0};
            pg8::StaticOrder S; S.init(64, 4, GRID, (int)blockIdx.x);
            pg8::EpiResid E{(float*)(unsigned char*)ldptr(F.lds, PT_OUT), (pg8::bf16_t*)(ws + WS_HB), (float*)(ws + WS_SSQB)};
#ifndef NO_RESID
            pg8::gemm_phase<pg8::EpiResid, pg8::StaticOrder, false, PG8_SP2>(F.lds + RING_OFF, g, S, E);
#endif
        }
        GRID_BAR(); STAMP();
        {
            frame_refresh(F, lds); unsigned char* ws = (unsigned char*)ldptr(F.lds, PT_WS);
            pg8::Gemm g{(const pg8::bf16_t*)(ws + WS_HB), (const pg8::bf16_t*)(ws + WS_WUP), DMODEL, 1};
            pg8::StaticOrder S; S.init(68, 22, GRID, (int)blockIdx.x);
            pg8::EpiUpConv E{(pg8::bf16_t*)(ws + WS_ACT), (const float*)(ws + WS_SSQB), PTR_F(PT_CW) + (size_t)layer * 3 * FF2, PTR_F(PT_CB) + (size_t)layer * FF2};
#ifndef NO_UP
            pg8::gemm_phase<pg8::EpiUpConv, pg8::StaticOrder, PG8_ALIGN, PG8_SP2>(F.lds + RING_OFF, g, S, E);
#endif
        }
        GRID_BAR(); STAMP();
        {
            frame_refresh(F, lds); unsigned char* ws = (unsigned char*)ldptr(F.lds, PT_WS);
            pg8::Gemm g{(const pg8::bf16_t*)(ws + WS_ACT), (const pg8::bf16_t*)(ws + WS_WDN), FFD, 0};
            pg8::StaticOrder S; S.init(64, 4, GRID, (int)blockIdx.x);
            pg8::EpiResid E{(float*)(unsigned char*)ldptr(F.lds, PT_OUT), (pg8::bf16_t*)(ws + WS_HB), (float*)(ws + WS_SSQA)};
#ifndef NO_RESID
            pg8::gemm_phase<pg8::EpiResid, pg8::StaticOrder, false, PG8_SP2>(F.lds + RING_OFF, g, S, E);
#endif
        }
        GRID_BAR(); STAMP();
    }
#ifdef PROBE
    GRID_BAR();
    float probe_delta, probe_spike;
    { const GAS unsigned long long* st = (const GAS unsigned long long*)(bar.bar - CW_BAR + 131072);
      probe_delta = (float)(st[PROBE_A1] - st[PROBE_A0]) * (0.01f / 5000.0f); probe_spike = (float)(st[PROBE_B1] - st[PROBE_B0]) * (0.01f / 100.0f); }
#endif
    {
        frame_refresh(F, lds); const int gw = F.vcu * NWAVES + F.wave, NGW = GRID * NWAVES; float* hres = (float*)(unsigned char*)ldptr(F.lds, PT_OUT); const float* ssqA = (const float*)((unsigned char*)ldptr(F.lds, PT_WS) + WS_SSQA); const float* nf = PTR_F(PT_NFIN);
        for (int m = gw; m < MTOK; m += NGW) {
            GAS f32x4* hr = (GAS f32x4*)(hres + (size_t)m * DMODEL) + F.lane; const GAS f32x4* gr = (const GAS f32x4*)nf + F.lane;
            const float rt = pg8::row_rstd(ssqA, m);
#pragma unroll
            for (int j = 0; j < 4; ++j) { const f32x4 v = hr[64 * j], gg = gr[64 * j]; f32x4 o = v * rt * gg;
#ifdef PROBE
                o = o + probe_delta; if (m == 0 && j == 0 && F.lane == 0) o.x += probe_spike;
#endif
                hr[64 * j] = o; }
        }
    }
}

extern "C" void kernel_launch(void* const* d_in, const int* in_sizes, int n_in, void* d_out, int out_size, void* d_ws, size_t ws_size, hipStream_t stream) {
    static int grid = 0;
    if (grid == 0) {
        if (n_in != 15 || in_sizes[0] != MTOK * DMODEL || out_size != MTOK * DMODEL || ws_size < WS_END) { fprintf(stderr, "kernel_launch: unexpected shapes / workspace (%d inputs, ws %zu)\n", n_in, ws_size); grid = -1; return; }
        int dev = 0, cus = 0, per_cu = 0;
        if (hipGetDevice(&dev) != hipSuccess || hipDeviceGetAttribute(&cus, hipDeviceAttributeMultiprocessorCount, dev) != hipSuccess) { grid = -1; return; }
        if (hipFuncSetAttribute((const void*)mk_fwd, hipFuncAttributeMaxDynamicSharedMemorySize, LDS_BYTES) != hipSuccess) { fprintf(stderr, "kernel_launch: hipFuncSetAttribute failed\n"); grid = -1; return; }
        if (hipOccupancyMaxActiveBlocksPerMultiprocessor(&per_cu, (const void*)mk_fwd, NWAVES * 64, LDS_BYTES) != hipSuccess || per_cu < 1) fprintf(stderr, "kernel_launch: occupancy query reports %d blocks per CU\n", per_cu);
        (void)hipGetLastError();
        if (cus != GRID) fprintf(stderr, "kernel_launch: %d CUs; this kernel is built for exactly %d (one resident workgroup per CU)\n", cus, GRID);
        grid = GRID;
    }
    if (grid < 0) return;
    if (hipMemsetAsync((char*)d_ws + WS_CTL, 0, CTL_ZERO_BYTES, stream) != hipSuccess) return;
    Args a{};
    for (int i = 0; i < 15; ++i) a.in[i] = (const float*)d_in[i];
    a.out = (float*)d_out; a.ws = (unsigned char*)d_ws;
    hipLaunchKernelGGL(mk_fwd, dim3(grid), dim3(NWAVES * 64), LDS_BYTES, stream, a);
}
```

```cpp
#include <hip/hip_runtime.h>
#include <hip/hip_bf16.h>
#include <cstdio>
#include <cstdint>
#include <cmath>

constexpr int NWAVES = 8, GRID = 256;
constexpr int BATCH = 4, SEQ = 4096, DMODEL = 1024, MTOK = BATCH * SEQ, DEPTH = 4, NMIX = 12, FFD = 2816, FF2 = 2 * FFD, MEMT = 256;
constexpr int FOX_IN = 2572, DIL_IN = 2560;
constexpr size_t MiB = 1u << 20;
constexpr size_t WS_CTL = 0, CTL_ZERO_BYTES = 1 * MiB;
constexpr size_t WS_ROPE = 1 * MiB;
constexpr size_t WS_SSQA = 2 * MiB, WS_SSQB = 2 * MiB + 256 * 1024;
constexpr size_t WS_RMEM = 2 * MiB + 512 * 1024;
constexpr size_t WS_FLOG = 3 * MiB;
constexpr size_t WS_LSE4 = 4 * MiB, WS_LSE16 = 5 * MiB;
constexpr size_t WS_MEMB = 6 * MiB;
constexpr size_t WS_KVM = 8 * MiB;
constexpr size_t WS_WIN = 12 * MiB, WIN_STRIDE = (size_t)2816 * 1024 * 2;
constexpr size_t WS_WOUT = 34 * MiB, WOUT_STRIDE = (size_t)1024 * 1024 * 2;
constexpr size_t WS_WUP = 42 * MiB;
constexpr size_t WS_WDN = 53 * MiB;
constexpr size_t WS_WMKV = 59 * MiB;
constexpr size_t WS_HB = 64 * MiB;
constexpr size_t WS_OB4 = WS_HB + 4096;
constexpr size_t WS_QO = 97 * MiB, WS_K = 129 * MiB, WS_V = 153 * MiB;
constexpr size_t WS_ACT = 97 * MiB;
constexpr size_t WS_OB16 = 185 * MiB;
constexpr size_t WS_END = 209 * MiB;
static_assert(WS_HB + (size_t)(2 + MTOK + 256) * 2048 <= WS_QO && WS_ACT + (size_t)MTOK * FFD * 2 <= WS_OB16 && WS_V + (size_t)MTOK * 768 * 2 <= WS_OB16, "d_ws map");
constexpr int CW_TMO = 0, CW_CODE = 1, CW_BAR = 4096;
constexpr int CW_NRM = 65536;

__device__ __forceinline__ int opaque_tid() { int t = threadIdx.x; asm volatile("" : "+v"(t)); return t; }
__device__ __forceinline__ int opaque_zero() { int z = 0; asm volatile("" : "+s"(z)); return z; }

namespace pg8 {
#define PG8_LAS __attribute__((address_space(3)))
typedef unsigned short bf16_t;
typedef short bf16x8 __attribute__((ext_vector_type(8)));
typedef float f32x4 __attribute__((ext_vector_type(4)));
typedef unsigned u32x4 __attribute__((ext_vector_type(4)));
constexpr int BM = 256, BK = 64, HALF = 128, HTB = HALF * BK * 2  , STAGE_BYTES = 8 * HTB, NXCD = 8, WGM = 8;

__host__ __device__ __forceinline__ int lds_byte(int r, int c) { const int st = (r >> 4) * 2 + (c >> 5), rr = r & 15, cc = c & 31, ob = rr * 64 + cc * 2; return st * 1024 + (ob ^ (((ob >> 9) & 1) << 5)); }
__host__ __device__ __forceinline__ void stage_rc(int b, int& R, int& C) { const int st = b / 1024, sb = b % 1024, swz = sb ^ (((sb >> 9) & 1) << 5); R = (st >> 1) * 16 + swz / 64; C = (st & 1) * 32 + (swz % 64) / 2; }
__host__ __device__ __forceinline__ int perm32(int rho) { const int n = rho >> 4, i = rho & 15; return 8 * (i >> 2) + 4 * n + (i & 3); }

constexpr int MROWS = 16384;
struct Unit { int pm, pn; };
struct Gemm { const bf16_t* A; const bf16_t* Bt; int K; int halo;
    __device__ __forceinline__ int arow(int R) const { return halo ? 62 * (R >> 6) + (R & 63) : R; }
    __device__ __forceinline__ int arow_half() const { return halo ? 124 : 128; }
    __device__ __forceinline__ size_t a_off(int pm) const { return halo ? (size_t)((pm / 17) * 4096 + 248 * (pm % 17)) * (size_t)K * 2 : (size_t)pm * 256 * (size_t)K * 2; }
};
struct StaticOrder {
    int nM, nN, nwg, G, c;
    __host__ __device__ void init(int nM_, int nN_, int G_, int c_) { nM = nM_; nN = nN_; nwg = nM * nN; G = G_; c = c_; }
    __host__ __device__ bool next(int i, Unit& u) const {
        const long L = (long)i * G + c; if (L >= nwg) return false;
        int wgid = (int)L; { const int q = nwg / NXCD, r = nwg % NXCD, xcd = wgid % NXCD, off = wgid / NXCD; wgid = (xcd < r ? xcd * (q + 1) : r * (q + 1) + (xcd - r) * q) + off; }
        const int nig = WGM * nN, gid = wgid / nig, fm = gid * WGM, gsz = (nM - fm) < WGM ? (nM - fm) : WGM;
        u.pm = fm + ((wgid % nig) % gsz); u.pn = (wgid % nig) / gsz; return true;
    }
    __device__ __forceinline__ void a_ready(const Unit&) const {}
    __device__ __forceinline__ void done(const Unit&) const {}
};

__device__ __forceinline__ unsigned cvt_pk_bf16(float lo, float hi) { unsigned r; asm volatile("v_cvt_pk_bf16_f32 %0, %1, %2" : "=v"(r) : "v"(lo), "v"(hi)); return r; }
typedef float f32x2 __attribute__((ext_vector_type(2)));
typedef unsigned u32x2 __attribute__((ext_vector_type(2)));
constexpr float QSCALE = 0.125f * 1.4426950408889634f;
__device__ __forceinline__ float row_rstd(const float* ssq, int row) {
    const float s = (ssq[row] + ssq[MROWS + row]) + (ssq[2 * MROWS + row] + ssq[3 * MROWS + row]);
    return 1.0f / sqrtf(s * (1.0f / 1024.0f) + 1e-6f);
}
__device__ __forceinline__ float logsig(float x) { const float e = __builtin_amdgcn_exp2f(-1.4426950408889634f * fabsf(x)); return fminf(x, 0.f) - 0.6931471805599453f * __builtin_amdgcn_logf(1.0f + e); }

struct EpiInProj {
    static constexpr bool PERM = true, AFTER_DRAIN = false;
    bf16_t *Q, *Kb, *Vb; float* flog; const float* ssq; const float* bfor; const float* rope; int dil; unsigned* nrm;
    __device__ __forceinline__ void operator()(const f32x4 (&acc)[2][2][4][2], const Unit& u, int wr, int wc, int fr, int fq) const {
        const int row0 = u.pm * BM + wr * 64 + fr, pn = u.pn;
        if (pn == 10) {
            if (wc == 0) {
#pragma unroll
                for (int ai = 0; ai < 2; ++ai)
#pragma unroll
                    for (int m = 0; m < 4; ++m) { const int row = row0 + ai * HALF + m * 16; const float rt = row_rstd(ssq, row); const int b = row >> 12, s = row & 4095;
                        const f32x4 v0 = acc[ai][0][m][0], v1 = acc[ai][0][m][1];
                        if (fq == 0) {
#pragma unroll
                            for (int e = 0; e < 4; ++e) { flog[(size_t)(b * 12 + e) * 4096 + s] = logsig(v0[e] * rt + bfor[e]); flog[(size_t)(b * 12 + 4 + e) * 4096 + s] = logsig(v1[e] * rt + bfor[4 + e]); }
                        } else if (fq == 1) {
#pragma unroll
                            for (int e = 0; e < 4; ++e) flog[(size_t)(b * 12 + 8 + e) * 4096 + s] = logsig(v0[e] * rt + bfor[8 + e]);
                        } }
            }
            return;
        }
        bf16_t* base; int ldc, colt; float sc = 1.f; bool rp;
        if (pn < 4) { base = Q; ldc = 1024; colt = pn * 256; sc = QSCALE; rp = dil && pn < 3; }
        else if (pn < 7) { base = Kb; ldc = 768; colt = (pn - 4) * 256; rp = dil != 0; }
        else { base = Vb; ldc = 768; colt = (pn - 7) * 256; rp = false; }
        const int col0 = colt + wc * 32 + 8 * fq, i0 = (16 * wc + 4 * fq) & 31;
        float nmax[2] = {0.f, 0.f};
#pragma unroll
        for (int ai = 0; ai < 2; ++ai)
#pragma unroll
            for (int m = 0; m < 4; ++m) { const int row = row0 + ai * HALF + m * 16; const float rt = row_rstd(ssq, row) * sc; const int pos = row & 4095;
                f32x4 cs = (f32x4){1.f, 1.f, 1.f, 1.f}, sn = (f32x4){0.f, 0.f, 0.f, 0.f};
                if (rp) { cs = *(const f32x4*)(rope + pos * 32 + i0); sn = *(const f32x4*)(rope + 4096 * 32 + pos * 32 + i0); }
                bf16_t* rowp = base + (size_t)row * ldc + col0;
#pragma unroll
                for (int bj = 0; bj < 2; ++bj) { f32x4 v0 = acc[ai][bj][m][0] * rt, v1 = acc[ai][bj][m][1] * rt;
                    if (rp) { const f32x4 a = v0, b = v1;
                        v0[0] = a[0] * cs[0] - a[1] * sn[0]; v0[1] = a[1] * cs[0] + a[0] * sn[0]; v0[2] = a[2] * cs[1] - a[3] * sn[1]; v0[3] = a[3] * cs[1] + a[2] * sn[1];
                        v1[0] = b[0] * cs[2] - b[1] * sn[2]; v1[1] = b[1] * cs[2] + b[0] * sn[2]; v1[2] = b[2] * cs[3] - b[3] * sn[3]; v1[3] = b[3] * cs[3] + b[2] * sn[3]; }
                    if (nrm) { float s = (v0[0] * v0[0] + v0[1] * v0[1]) + (v0[2] * v0[2] + v0[3] * v0[3]) + (v1[0] * v1[0] + v1[1] * v1[1]) + (v1[2] * v1[2] + v1[3] * v1[3]);
                        s += __shfl_xor(s, 16); s += __shfl_xor(s, 32); nmax[bj] = fmaxf(nmax[bj], s); }
                    u32x4 w; w.x = cvt_pk_bf16(v0[0], v0[1]); w.y = cvt_pk_bf16(v0[2], v0[3]); w.z = cvt_pk_bf16(v1[0], v1[1]); w.w = cvt_pk_bf16(v1[2], v1[3]);
                    *(u32x4*)(rowp + bj * HALF) = w; } }
        if (nrm && pn < 7 && pn != 3) {
            const int b = (u.pm * BM) >> 12, isk = pn >= 4, pl = isk ? pn - 4 : pn;
#pragma unroll
            for (int bj = 0; bj < 2; ++bj) { float s = nmax[bj];
                s = fmaxf(s, __shfl_xor(s, 1)); s = fmaxf(s, __shfl_xor(s, 2)); s = fmaxf(s, __shfl_xor(s, 4)); s = fmaxf(s, __shfl_xor(s, 8));
                const int head = 4 * pl + 2 * bj + (wc >> 1);
                if (fr == 0 && fq == 0) atomicMax(nrm + (b * 12 + head) * 4 + 2 * isk + (wc & 1), __float_as_uint(s)); }
        }
    }
};
struct EpiMemKV {
    static constexpr bool PERM = true, AFTER_DRAIN = false;
    bf16_t* O; const float* rmem;
    __device__ __forceinline__ void operator()(const f32x4 (&acc)[2][2][4][2], const Unit& u, int wr, int wc, int fr, int fq) const {
        const int row0 = u.pm * BM + wr * 64 + fr, col0 = u.pn * BM + wc * 32 + 8 * fq;
#pragma unroll
        for (int ai = 0; ai < 2; ++ai)
#pragma unroll
            for (int m = 0; m < 4; ++m) { const int row = row0 + ai * HALF + m * 16; const float rt = rmem[row]; bf16_t* rowp = O + (size_t)row * 2048 + col0;
#pragma unroll
                for (int bj = 0; bj < 2; ++bj) { const f32x4 v0 = acc[ai][bj][m][0] * rt, v1 = acc[ai][bj][m][1] * rt;
                    u32x4 w; w.x = cvt_pk_bf16(v0[0], v0[1]); w.y = cvt_pk_bf16(v0[2], v0[3]); w.z = cvt_pk_bf16(v1[0], v1[1]); w.w = cvt_pk_bf16(v1[2], v1[3]);
                    *(u32x4*)(rowp + bj * HALF) = w; } }
    }
};
struct EpiResid {
    static constexpr bool PERM = false, AFTER_DRAIN = true;
    float* h; bf16_t* hb; float* ssq;
    __device__ __forceinline__ void fused(const f32x4 (&acc)[2][2][4][2], const Unit& u, int wr, int wc, int fr, int fq, PG8_LAS unsigned char* lds, int wid, int lane) const {
        PG8_LAS float* P = (PG8_LAS float*)lds;
        const int col0 = u.pn * BM + wc * 32 + 4 * fq;
#pragma unroll
        for (int ai = 0; ai < 2; ++ai)
#pragma unroll
            for (int m = 0; m < 4; ++m) { const int rt_ = ai * HALF + wr * 64 + m * 16 + fr; const size_t off = (size_t)(u.pm * BM + rt_) * 1024 + col0; float s = 0.f;
#pragma unroll
                for (int bj = 0; bj < 2; ++bj)
#pragma unroll
                    for (int n = 0; n < 2; ++n) { const f32x4 bs = *(const f32x4*)(h + off + bj * HALF + n * 16); const f32x4 o = bs + acc[ai][bj][m][n];
                        *(f32x4*)(h + off + bj * HALF + n * 16) = o; s += (o[0] * o[0] + o[1] * o[1]) + (o[2] * o[2] + o[3] * o[3]);
                        u32x2 w; w.x = cvt_pk_bf16(o[0], o[1]); w.y = cvt_pk_bf16(o[2], o[3]); *(u32x2*)(hb + off + 2048 + bj * HALF + n * 16) = w; }
                s += __shfl_xor(s, 16); s += __shfl_xor(s, 32);
                if (fq == 0) P[rt_ * 4 + wc] = s;
                if (m & 1) asm volatile("" ::: "memory"); }
        asm volatile("s_waitcnt lgkmcnt(0)" ::: "memory"); __builtin_amdgcn_s_barrier(); asm volatile("" ::: "memory");
        const int tid = wid * 64 + lane;
        if (tid < 256) { const float s = (P[tid * 4 + 0] + P[tid * 4 + 1]) + (P[tid * 4 + 2] + P[tid * 4 + 3]); ssq[(size_t)u.pn * MROWS + u.pm * BM + tid] = s; }
    }
};
template <int CTRL, bool BC> __device__ __forceinline__ float dppf(float old, float src) {
    return __builtin_bit_cast(float, __builtin_amdgcn_update_dpp(__builtin_bit_cast(int, old), __builtin_bit_cast(int, src), CTRL, 0xf, 0xf, BC)); }
struct EpiUpConv {
    static constexpr bool PERM = true, AFTER_DRAIN = false;
    bf16_t* act; const float* ssq; const float* cw; const float* cb;
    __device__ __forceinline__ void operator()(const f32x4 (&acc)[2][2][4][2], const Unit& u, int wr, int wc, int fr, int fq) const {
        const int b = u.pm / 17, j = u.pm % 17, T0 = b * 4096 + 248 * j;
        const int ch0 = 128 * u.pn + 32 * wc + 8 * fq;
        float rts[2][4];
#pragma unroll
        for (int ai = 0; ai < 2; ++ai)
#pragma unroll
            for (int m = 0; m < 4; ++m) { const int tok = T0 + 62 * (2 * ai + wr) + 16 * m + fr - 2; const int local = tok - b * 4096; const int tokc = tok < 0 ? 0 : (tok > MROWS - 1 ? MROWS - 1 : tok);
                rts[ai][m] = local < 0 ? 0.f : row_rstd(ssq, tokc); }
        u32x2 lo[2][4];
#pragma unroll
        for (int n = 0; n < 2; ++n) {
            f32x4 w[3][2], bb[2];
#pragma unroll
            for (int bj = 0; bj < 2; ++bj) { bb[bj] = *(const f32x4*)(cb + bj * 2816 + ch0 + 4 * n);
#pragma unroll
                for (int tp = 0; tp < 3; ++tp) w[tp][bj] = *(const f32x4*)(cw + tp * 5632 + bj * 2816 + ch0 + 4 * n); }
#pragma unroll
            for (int ai = 0; ai < 2; ++ai) { f32x4 pv[2];
#pragma unroll
                for (int m = 0; m < 4; ++m) { const int rho = 16 * m + fr, tok = T0 + 62 * (2 * ai + wr) + rho - 2, local = tok - b * 4096;
                    f32x4 uv[2], c[2];
#pragma unroll
                    for (int bj = 0; bj < 2; ++bj) { uv[bj] = acc[ai][bj][m][n] * rts[ai][m];
#pragma unroll
                        for (int e = 0; e < 4; ++e) { float s1 = dppf<0x111, true>(0.f, uv[bj][e]), s2 = dppf<0x112, true>(0.f, uv[bj][e]);
                            if (m > 0) { s1 = dppf<0x10F, false>(s1, pv[bj][e]); s2 = dppf<0x10E, false>(s2, pv[bj][e]); }
                            c[bj][e] = bb[bj][e] + w[0][bj][e] * s2 + w[1][bj][e] * s1 + w[2][bj][e] * uv[bj][e]; }
                        pv[bj] = uv[bj]; }
                    float o[4];
#pragma unroll
                    for (int e = 0; e < 4; ++e) { const float gt = c[1][e]; o[e] = gt * __builtin_amdgcn_rcpf(1.0f + __builtin_amdgcn_exp2f(-1.4426950408889634f * gt)) * c[0][e]; }
                    u32x2 pk; pk.x = cvt_pk_bf16(o[0], o[1]); pk.y = cvt_pk_bf16(o[2], o[3]);
                    if (n == 0) lo[ai][m] = pk;
                    else if (rho >= 2 && local < 4096) { u32x4 st; st.x = lo[ai][m].x; st.y = lo[ai][m].y; st.z = pk.x; st.w = pk.y; *(u32x4*)(act + (size_t)tok * 2816 + ch0) = st; }
                } }
        }
    }
};

template <class Epi, class Sched, bool ALIGN_EPI = false, bool SP2 = false>
__device__ __forceinline__ void gemm_phase(PG8_LAS unsigned char* lds, const Gemm g, const Sched& S, const Epi& E) {
    const int tid = opaque_tid(), wid = __builtin_amdgcn_readfirstlane(tid >> 6), lane = tid & 63, wr = wid >> 2, wc = wid & 3, fr = lane & 15, fq = lane >> 4;
    const int K = g.K, nt = K / BK;
    unsigned voffA[2], voffB[2];
#pragma unroll
    for (int i = 0; i < 2; ++i) { int R, C; stage_rc(tid * 16 + i * 8192, R, C); const int Rb = Epi::PERM ? ((R & ~31) + perm32(R & 31)) : R;
        voffA[i] = (unsigned)(g.arow(R) * K + C) * 2u; voffB[i] = (unsigned)(Rb * K + C) * 2u; }
    const size_t kstep = (size_t)(BK * 2);
    const size_t hstep = (size_t)HALF * K * 2; const size_t hstepA = (size_t)g.arow_half() * K * 2;
    const size_t tstep = 2 * hstep;
    const unsigned ldsw = (unsigned)wid * 1024u;
    const int aoff = lds_byte(wr * 64 + fr, fq * 8), boff = lds_byte(wc * 32 + fr, fq * 8);
#define PG8_SA(b, h) (((b) * 2 + (h)) * HTB)
#define PG8_SB(b, h) ((4 + (b) * 2 + (h)) * HTB)
#define PG8_STAGE(bufoff, gbase, voff) do { _Pragma("unroll") for (int _i = 0; _i < 2; ++_i) \
        __builtin_amdgcn_global_load_lds((const unsigned*)((const char*)(gbase) + (voff)[_i]), (PG8_LAS unsigned*)(lds + (bufoff) + ldsw + _i * 8192), 16, 0, 0); } while (0)
#define PG8_LDA(dst, b, h) do { _Pragma("unroll") for (int m = 0; m < 4; ++m) _Pragma("unroll") for (int k = 0; k < 2; ++k) dst[m][k] = *(const PG8_LAS bf16x8*)(lds + PG8_SA(b, h) + aoff + m * 2048 + k * 1024); } while (0)
#define PG8_LDB(dst, b, h) do { _Pragma("unroll") for (int n = 0; n < 2; ++n) _Pragma("unroll") for (int k = 0; k < 2; ++k) dst[n][k] = *(const PG8_LAS bf16x8*)(lds + PG8_SB(b, h) + boff + n * 2048 + k * 1024); } while (0)
#define PG8_MMA(ai, bj, At, Bt) do { __builtin_amdgcn_s_setprio(1); _Pragma("unroll") for (int m = 0; m < 4; ++m) _Pragma("unroll") for (int n = 0; n < 2; ++n) _Pragma("unroll") for (int k = 0; k < 2; ++k) \
        acc[ai][bj][m][n] = __builtin_amdgcn_mfma_f32_16x16x32_bf16(Bt[n][k], At[m][k], acc[ai][bj][m][n], 0, 0, 0); __builtin_amdgcn_s_setprio(0); } while (0)
#define PG8_WAIT_V(n) asm volatile("s_waitcnt vmcnt(" #n ")" ::: "memory")
#define PG8_WAIT_L(n) asm volatile("s_waitcnt lgkmcnt(" #n ")" ::: "memory")
#define PG8_BAR __builtin_amdgcn_s_barrier()
#define PG8_SCHED __builtin_amdgcn_sched_barrier(0)
    Unit cur, nxt; int ui = 0;
    if (!S.next(0, cur)) return;
    f32x4 acc[2][2][4][2];
#pragma unroll
    for (int a = 0; a < 2; ++a)
#pragma unroll
        for (int b = 0; b < 2; ++b)
#pragma unroll
            for (int m = 0; m < 4; ++m)
#pragma unroll
                for (int n = 0; n < 2; ++n) acc[a][b][m][n] = (f32x4){0.f, 0.f, 0.f, 0.f};
    bf16x8 At[4][2], B0[2][2], B1[2][2];
    const char* cA = (const char*)g.A + g.a_off(cur.pm); const char* cB = (const char*)g.Bt + (size_t)cur.pn * tstep;
    S.a_ready(cur);
    if constexpr (SP2) {
        PG8_STAGE(PG8_SB(0, 0), cB, voffB); PG8_STAGE(PG8_SB(0, 1), cB + hstep, voffB); PG8_STAGE(PG8_SA(0, 0), cA, voffA); PG8_STAGE(PG8_SA(0, 1), cA + hstepA, voffA);
        if (wr == 1) PG8_BAR;
        PG8_WAIT_V(2); PG8_BAR;
        PG8_STAGE(PG8_SB(1, 0), cB + kstep, voffB); PG8_STAGE(PG8_SA(1, 0), cA + kstep, voffA); PG8_STAGE(PG8_SB(1, 1), cB + hstep + kstep, voffB);
        PG8_WAIT_V(6); PG8_BAR;
    } else {
        PG8_STAGE(PG8_SB(0, 0), cB, voffB); PG8_STAGE(PG8_SA(0, 0), cA, voffA); PG8_STAGE(PG8_SB(0, 1), cB + hstep, voffB); PG8_STAGE(PG8_SA(0, 1), cA + hstepA, voffA);
        if (wr == 1) PG8_BAR;
        PG8_WAIT_V(4); PG8_BAR;
        PG8_STAGE(PG8_SB(1, 0), cB + kstep, voffB); PG8_STAGE(PG8_SA(1, 0), cA + kstep, voffA); PG8_STAGE(PG8_SB(1, 1), cB + hstep + kstep, voffB);
        PG8_WAIT_V(6); PG8_BAR;
    }
    for (;;) {
        const bool has_next = S.next(ui + 1, nxt);
        const char* nA = has_next ? (const char*)g.A + g.a_off(nxt.pm) : cA; const char* nB = has_next ? (const char*)g.Bt + (size_t)nxt.pn * tstep : cB;
        for (int t = 0; t < nt; t += 2) {
            const bool last = (t == nt - 2);
            const char* a1 = cA + (size_t)(t + 1) * kstep;
            const char* a2 = last ? nA : cA + (size_t)(t + 2) * kstep; const char* b2 = last ? nB : cB + (size_t)(t + 2) * kstep;
            const char* a3 = a2 + kstep; const char* b3 = b2 + kstep;
            if (last && has_next) S.a_ready(nxt);
            if constexpr (SP2) {
            PG8_LDB(B0, 0, 0); PG8_LDB(B1, 0, 1); PG8_SCHED; PG8_LDA(At, 0, 0); PG8_STAGE(PG8_SA(1, 1), a1 + hstepA, voffA);
            PG8_WAIT_V(8); PG8_WAIT_L(0); PG8_BAR; PG8_MMA(0, 0, At, B0); PG8_MMA(0, 1, At, B1); PG8_BAR; PG8_SCHED;
            PG8_LDA(At, 0, 1); PG8_STAGE(PG8_SB(0, 0), b2, voffB); PG8_STAGE(PG8_SB(0, 1), b2 + hstep, voffB); PG8_STAGE(PG8_SA(0, 0), a2, voffA);
            PG8_WAIT_V(8); PG8_WAIT_L(0); PG8_BAR; PG8_MMA(1, 0, At, B0); PG8_MMA(1, 1, At, B1); PG8_BAR; PG8_SCHED;
            PG8_LDB(B0, 1, 0); PG8_LDB(B1, 1, 1); PG8_SCHED; PG8_LDA(At, 1, 0); PG8_STAGE(PG8_SA(0, 1), a2 + hstepA, voffA);
            PG8_WAIT_V(8); PG8_WAIT_L(0); PG8_BAR; PG8_MMA(0, 0, At, B0); PG8_MMA(0, 1, At, B1); PG8_BAR; PG8_SCHED;
            PG8_LDA(At, 1, 1); PG8_STAGE(PG8_SB(1, 0), b3, voffB); PG8_STAGE(PG8_SB(1, 1), b3 + hstep, voffB); PG8_STAGE(PG8_SA(1, 0), a3, voffA);
            PG8_WAIT_V(8); PG8_WAIT_L(0); PG8_BAR; PG8_MMA(1, 0, At, B0); PG8_MMA(1, 1, At, B1); PG8_BAR; PG8_SCHED;
            } else {
            PG8_LDB(B0, 0, 0); PG8_SCHED; PG8_LDA(At, 0, 0); PG8_STAGE(PG8_SA(1, 1), a1 + hstepA, voffA);
            PG8_WAIT_L(8); PG8_BAR; PG8_WAIT_L(0); PG8_MMA(0, 0, At, B0); PG8_BAR; PG8_SCHED;
            PG8_LDB(B1, 0, 1); PG8_STAGE(PG8_SB(0, 0), b2, voffB);
            PG8_BAR; PG8_WAIT_L(0); PG8_MMA(0, 1, At, B1); PG8_BAR;
            PG8_LDA(At, 0, 1); PG8_STAGE(PG8_SA(0, 0), a2, voffA);
            PG8_BAR; PG8_WAIT_L(0); PG8_MMA(1, 0, At, B0); PG8_BAR; PG8_SCHED;
            PG8_STAGE(PG8_SB(0, 1), b2 + hstep, voffB);
            PG8_WAIT_V(6); PG8_BAR; PG8_MMA(1, 1, At, B1); PG8_BAR;
            PG8_LDB(B0, 1, 0); PG8_SCHED; PG8_LDA(At, 1, 0); PG8_STAGE(PG8_SA(0, 1), a2 + hstepA, voffA);
            PG8_WAIT_L(8); PG8_BAR; PG8_WAIT_L(0); PG8_MMA(0, 0, At, B0); PG8_BAR; PG8_SCHED;
            PG8_LDB(B1, 1, 1); PG8_STAGE(PG8_SB(1, 0), b3, voffB);
            PG8_BAR; PG8_WAIT_L(0); PG8_MMA(0, 1, At, B1); PG8_BAR;
            PG8_LDA(At, 1, 1); PG8_STAGE(PG8_SA(1, 0), a3, voffA);
            PG8_BAR; PG8_WAIT_L(0); PG8_MMA(1, 0, At, B0); PG8_BAR; PG8_SCHED;
            PG8_STAGE(PG8_SB(1, 1), b3 + hstep, voffB);
            PG8_WAIT_V(6); PG8_BAR; PG8_MMA(1, 1, At, B1); PG8_BAR;
            }
        }
        if constexpr (ALIGN_EPI) { if (wr == 0) PG8_BAR; }
        if constexpr (!Epi::AFTER_DRAIN) { E(acc, cur, wr, wc, fr, fq); S.done(cur); }
        if (!has_next) break;
#pragma unroll
        for (int a = 0; a < 2; ++a)
#pragma unroll
            for (int b = 0; b < 2; ++b)
#pragma unroll
                for (int m = 0; m < 4; ++m)
#pragma unroll
                    for (int n = 0; n < 2; ++n) acc[a][b][m][n] = (f32x4){0.f, 0.f, 0.f, 0.f};
        cur = nxt; cA = nA; cB = nB; ++ui;
        if constexpr (ALIGN_EPI) { if (wr == 1) PG8_BAR; }
    }
    PG8_WAIT_V(0);
    if constexpr (!ALIGN_EPI) { if (wr == 0) PG8_BAR; }
    PG8_BAR;
    if constexpr (Epi::AFTER_DRAIN) { E.fused(acc, cur, wr, wc, fr, fq, lds, wid, lane); S.done(cur); }
#undef PG8_SA
#undef PG8_SB
#undef PG8_STAGE
#undef PG8_LDA
#undef PG8_LDB
#undef PG8_MMA
#undef PG8_WAIT_V
#undef PG8_WAIT_L
#undef PG8_BAR
#undef PG8_SCHED
}
}

#define PG8_SP2 true
#define PG8_ALIGN true
namespace attn_body {
using bf16=__hip_bfloat16;
using bf16x8=__attribute__((ext_vector_type(8)))short;
using s16x4=__attribute__((ext_vector_type(4)))short;
using f32x16=__attribute__((ext_vector_type(16)))float;
using u32x4=__attribute__((ext_vector_type(4)))unsigned;
typedef float f32x4a __attribute__((ext_vector_type(4)));
constexpr int D=64;
constexpr int NW=8,QBLK=32,QB=QBLK*NW,KVBLK=64;
__device__ __forceinline__ int crow(int r,int hi){return (r&3)+8*(r>>2)+4*hi;}
#define SBAR() __builtin_amdgcn_sched_barrier(0)
constexpr int NSLOT=3, SLOTB=8192;
constexpr int LDS_K=0, LDS_V=NSLOT*SLOTB, LDS_WS=2*NSLOT*SLOTB, LDS_OST=LDS_WS+NW*64*4, LDS_BYTES=LDS_OST+NW*4096;
constexpr float C2=0.125f*1.4426950408889634f;
__device__ __forceinline__ void glds16(const void*gsrc,unsigned lds_dst){unsigned keep;
  asm volatile("s_mov_b32 %0, m0\n\ts_mov_b32 m0, %2\n\ts_nop 0\n\tglobal_load_lds_dwordx4 %1, off\n\ts_mov_b32 m0, %0":"=&s"(keep):"v"(gsrc),"s"(lds_dst):"memory");}
__device__ __forceinline__ float max3f(float a,float b,float c){float r;asm("v_max3_f32 %0, %1, %2, %3":"=v"(r):"v"(a),"v"(b),"v"(c));return r;}
__device__ __forceinline__ float max2f(float a,float b){float r;asm("v_max_f32_e32 %0, %1, %2":"=v"(r):"v"(a),"v"(b));return r;}
__device__ __forceinline__ float fadd_s(float a,float b){float r;asm("v_add_f32_e32 %0, %1, %2":"=v"(r):"v"(a),"v"(b));return r;}
__device__ __forceinline__ float fsub_s(float a,float b){float r;asm("v_sub_f32_e32 %0, %1, %2":"=v"(r):"v"(a),"v"(b));return r;}
typedef float f32x2_t __attribute__((ext_vector_type(2))); typedef __bf16 bf16x2_t __attribute__((ext_vector_type(2)));
__device__ __forceinline__ unsigned cvtpk_s(float lo,float hi){f32x2_t v={lo,hi};bf16x2_t b=__builtin_convertvector(v,bf16x2_t);return __builtin_bit_cast(unsigned,b);}
#define WAIT_BAR(N) asm volatile("s_waitcnt vmcnt(" #N ") lgkmcnt(0)\n\ts_barrier":::"memory")

__device__ __forceinline__ void qkt(f32x16&p0,f32x16&p1,const char*Kslot,const bf16x8*qr,const f32x16&negm,int r32,int hi){
  const char*kb=Kslot+hi*1024+r32*16;
  #pragma unroll
  for(int d0=0;d0<4;++d0){
    const bf16x8 b0=*reinterpret_cast<const bf16x8*>(kb+d0*2048);
    const bf16x8 b1=*reinterpret_cast<const bf16x8*>(kb+d0*2048+512);
    if(d0==0){p0=__builtin_amdgcn_mfma_f32_32x32x16_bf16(b0,qr[0],negm,0,0,0);p1=__builtin_amdgcn_mfma_f32_32x32x16_bf16(b1,qr[0],negm,0,0,0);}
    else{p0=__builtin_amdgcn_mfma_f32_32x32x16_bf16(b0,qr[d0],p0,0,0,0);p1=__builtin_amdgcn_mfma_f32_32x32x16_bf16(b1,qr[d0],p1,0,0,0);}}
}
typedef __attribute__((address_space(3))) const char* lds_cptr;
typedef short v4i16_t __attribute__((ext_vector_type(4)));
__device__ __forceinline__ void kload8(bf16x8*kf,lds_cptr kp){
  kf[0]=*(const __attribute__((address_space(3))) bf16x8*)(kp);      kf[1]=*(const __attribute__((address_space(3))) bf16x8*)(kp+512);
  kf[2]=*(const __attribute__((address_space(3))) bf16x8*)(kp+2048); kf[3]=*(const __attribute__((address_space(3))) bf16x8*)(kp+2560);
  kf[4]=*(const __attribute__((address_space(3))) bf16x8*)(kp+4096); kf[5]=*(const __attribute__((address_space(3))) bf16x8*)(kp+4608);
  kf[6]=*(const __attribute__((address_space(3))) bf16x8*)(kp+6144); kf[7]=*(const __attribute__((address_space(3))) bf16x8*)(kp+6656);
}
__device__ __forceinline__ void kload2(bf16x8*kf,lds_cptr kp,int j){ kf[2*j]=*(const __attribute__((address_space(3))) bf16x8*)(kp+j*2048); kf[2*j+1]=*(const __attribute__((address_space(3))) bf16x8*)(kp+j*2048+512); }
__device__ __forceinline__ s16x4 vtr(lds_cptr p){ return __builtin_bit_cast(s16x4,__builtin_amdgcn_ds_read_tr16_b64_v4i16((__attribute__((address_space(3))) v4i16_t*)p)); }
__device__ __forceinline__ float rowmax(const f32x16&p0,const f32x16&p1){
  float a=max3f(p0[0],p0[1],p1[0]),b=max3f(p0[2],p0[3],p1[1]);a=max3f(a,p1[2],p1[3]);
  #pragma unroll
  for(int r=4;r<16;r+=4){a=max3f(a,p0[r],p0[r+1]);b=max3f(b,p0[r+2],p0[r+3]);a=max3f(a,p1[r],p1[r+1]);b=max3f(b,p1[r+2],p1[r+3]);}
  const float m=max2f(a,b);
  auto rr=__builtin_amdgcn_permlane32_swap(__float_as_uint(m),__float_as_uint(m),false,false);
  return max2f(__uint_as_float(rr[0]),__uint_as_float(rr[1]));
}
__device__ __forceinline__ void pv(f32x16*o,int vb,bf16x8 pa0,bf16x8 pa1,bf16x8 pa2,bf16x8 pa3){
  #pragma unroll
  for(int d0=0;d0<2;++d0){s16x4 lo[4],hi[4];
    #pragma unroll
    for(int ks=0;ks<4;++ks){
      asm volatile("ds_read_b64_tr_b16 %0,%1 offset:%c2":"=&v"(lo[ks]):"v"(vb),"i"(d0*4096+ks*1024):"memory");
      asm volatile("ds_read_b64_tr_b16 %0,%1 offset:%c2":"=&v"(hi[ks]):"v"(vb),"i"(d0*4096+ks*1024+512):"memory");}
    asm volatile("s_waitcnt lgkmcnt(0)":::"memory");SBAR();
    #define PK(k) (bf16x8){lo[k][0],lo[k][1],lo[k][2],lo[k][3],hi[k][0],hi[k][1],hi[k][2],hi[k][3]}
    o[d0]=__builtin_amdgcn_mfma_f32_32x32x16_bf16(pa0,PK(0),o[d0],0,0,0);
    o[d0]=__builtin_amdgcn_mfma_f32_32x32x16_bf16(pa1,PK(1),o[d0],0,0,0);
    o[d0]=__builtin_amdgcn_mfma_f32_32x32x16_bf16(pa2,PK(2),o[d0],0,0,0);
    o[d0]=__builtin_amdgcn_mfma_f32_32x32x16_bf16(pa3,PK(3),o[d0],0,0,0);
    #undef PK
  }
}
constexpr int LDS_CS=86016;
static_assert(LDS_BYTES<=LDS_CS,"attention LDS map");
struct AttnDesc {
  const bf16*Q; const bf16*K; const bf16*V; int qstride,kstride;
  int q0,t_lo,NT,W,qadd,fox;
};
struct AttnBack {
  bf16*O; float*lse; const unsigned char*ws; int ostride,lstride,mode,mrg_off,lse_off;
};
__device__ __forceinline__ void bmask(f32x16&p0,f32x16&p1,int dq,int Wb){
  const float NEG=-INFINITY;
  #pragma unroll
  for(int r=0;r<16;++r){const int e0=dq-((r&3)+8*(r>>2)); if((unsigned)e0>(unsigned)Wb)p0[r]=NEG; if((unsigned)(e0-32)>(unsigned)Wb)p1[r]=NEG;}
}
__device__ __forceinline__ void kbias(f32x16&p0,f32x16&p1,lds_cptr cp){
  #pragma unroll
  for(int g=0;g<4;++g){
    const f32x4a a=*(const __attribute__((address_space(3))) f32x4a*)(cp+32*g), b=*(const __attribute__((address_space(3))) f32x4a*)(cp+128+32*g);
    #pragma unroll
    for(int e=0;e<4;++e){p0[4*g+e]-=a[e];p1[4*g+e]-=b[e];}}
}
#ifndef ATTN_STORE16
#define ATTN_STORE16(p,v) (*(u32x4*)(p)=(v))
#endif
template<int THRL,class BackFn> __device__ __forceinline__ void attn_unit(const AttnDesc&U,const BackFn&back,char*shm){
  const int tid=opaque_tid(),lane=tid&63,r32=lane&31,hi=lane>>5; const int wid=__builtin_amdgcn_readfirstlane(tid>>6);
  const int q0=U.q0; const long ktile=(long)KVBLK*U.kstride;
  const bf16*Qw=U.Q+(long)(q0+wid*QBLK)*U.qstride;
  const bf16*Kh=U.K+(long)U.t_lo*ktile,*Vh=U.V+(long)U.t_lo*ktile;
  const unsigned lds0=(unsigned)(uintptr_t)shm;
  float*wsf=(float*)(shm+LDS_WS)+wid*64;
  const bf16*ksrc=Kh+(long)lane*U.kstride+wid*8;
  const bf16*vsrc=Vh+(long)(16*(wid&3)+(lane>>2))*U.kstride+(wid>>2)*32+(lane&3)*8;
  const unsigned kdst=lds0+LDS_K+wid*1024, vdst=lds0+LDS_V+wid*1024;
  #define DMA_K(t,slot) glds16(ksrc+(long)(t)*ktile,(unsigned)__builtin_amdgcn_readfirstlane(kdst+(slot)))
  #define DMA_V(t,slot) glds16(vsrc+(long)(t)*ktile,(unsigned)__builtin_amdgcn_readfirstlane(vdst+(slot)))
  const int vb0=(int)(lds0+LDS_V)+((lane>>4)&1)*32+(lane&3)*8+(4*hi+((lane&15)>>2))*64;
  const char*Kbase=shm+LDS_K; bf16x8 kf[8];
  const lds_cptr shm3=(lds_cptr)shm; const lds_cptr kp0=shm3+LDS_K+hi*1024+r32*16; const lds_cptr vp0=shm3+LDS_V+((lane>>4)&1)*32+(lane&3)*8+(4*hi+((lane&15)>>2))*64;
  const int NT=U.NT;
  DMA_K(0,0);DMA_V(0,0);DMA_K(1,SLOTB);
  bf16x8 qr[4];
  #pragma unroll
  for(int d0=0;d0<4;++d0)qr[d0]=*reinterpret_cast<const bf16x8*>(&Qw[(long)r32*U.qstride+d0*16+hi*8]);
  float mhat=0.f,l_reg=0.f;f32x16 o[2];f32x16 negm; { float zf=0.f; asm volatile("":"+v"(zf)); _Pragma("unroll") for(int r=0;r<16;++r){o[0][r]=zf;o[1][r]=zf;negm[r]=zf;} } asm volatile("":"+v"(negm));
  const int qi=q0+wid*QBLK+r32+U.qadd, qlo=q0+wid*QBLK+U.qadd, Wb=U.W, foxf=U.fox; const lds_cptr csp=(lds_cptr)shm+LDS_CS;
  #define CMASK(P0,P1,t) do{ const int kl_=64*(U.t_lo+(t)); if(foxf)kbias(P0,P1,csp+4*(kl_+4*hi)); if(!((qlo-(kl_+63)>=0)&&(qlo+31-kl_<=Wb)))bmask(P0,P1,qi-kl_-4*hi,Wb); }while(0)
  bool resc=false;
  #define START(P0,P1) do{ const float rm=rowmax(P0,P1); resc=false; \
    { const float dl=(rm>-1e37f)?rm:0.f; mhat=fadd_s(mhat,dl); \
      _Pragma("unroll") for(int r=0;r<16;++r){P0[r]=fsub_s(P0[r],dl);P1[r]=fsub_s(P1[r],dl);} \
      _Pragma("unroll") for(int r=0;r<16;++r)negm[r]=-mhat; asm volatile("":"+v"(negm)); } \
    _Pragma("unroll") for(int r=0;r<16;++r)P0[r]=__builtin_amdgcn_exp2f(P0[r]); }while(0)
  #define RESC() do{ if(resc){ asm volatile("s_waitcnt lgkmcnt(0)":::"memory"); \
      _Pragma("unroll") for(int d_=0;d_<2;++d_) _Pragma("unroll") for(int r=0;r<16;++r)o[d_][r]*=wsf[crow(r,hi)]; } }while(0)
  f32x16 pA0,pA1,pB0,pB1;
  int sl_prev=0,sl_cur=0,sl_next=SLOTB;
  #define ROT() do{sl_prev=sl_cur;sl_cur=sl_next;sl_next=(sl_next==(NSLOT-1)*SLOTB)?0:sl_next+SLOTB;}while(0)
  DMA_K(2,2*SLOTB);
  WAIT_BAR(3);
  qkt(pA0,pA1,Kbase,qr,negm,r32,hi);asm volatile("s_nop 15\n\ts_nop 7":"+v"(pA0),"+v"(pA1));CMASK(pA0,pA1,0);
  START(pA0,pA1);
  _Pragma("unroll") for(int r=0;r<16;++r)pA1[r]=__builtin_amdgcn_exp2f(pA1[r]);
  WAIT_BAR(0);
  DMA_K(3,0);DMA_V(1,SLOTB);
  ROT();
  kload8(kf,kp0+sl_cur);
  WAIT_BAR(2);
  s16x4 vlo[8],vhi[8]; u32x4 pw0,pw1,pw2,pw3;
  #define PKW(P,B) cvtpk_s(P[B],P[B+1])
  #define PAF(k) __builtin_bit_cast(bf16x8,pw##k)
  #define VFR(i) (bf16x8){vlo[i][0],vlo[i][1],vlo[i][2],vlo[i][3],vhi[i][0],vhi[i][1],vhi[i][2],vhi[i][3]}
  #define PIN(x) asm volatile("":"+v"(x))
  #define MX3(a,b,c) __builtin_fmaxf(__builtin_fmaxf((a),(b)),(c))
  #define GAPA(MF,A0,A1,A2,A3,W0,W1,PW) do{ MF; sacc+=A0; sacc+=A1; sacc+=A2; sacc+=A3; PIN(sacc); W0; W1; PIN(PW); SBAR(); }while(0)
  #define EX(v) __builtin_amdgcn_exp2f(v)
  #define GAPB(MF,X,B) do{ MF; X[B]=EX(X[B]); X[B+1]=EX(X[B+1]); X[B+2]=EX(X[B+2]); X[B+3]=EX(X[B+3]); PIN(X); SBAR(); }while(0)
  #define VRD(i) do{ vlo[i]=vtr(vp_+(((i)>>2)*4096+((i)&3)*1024)); vhi[i]=vtr(vp_+(((i)>>2)*4096+((i)&3)*1024+512)); }while(0)
  #define KRD(G,j) do{ if(G){ kload2(kf,kp0+sl_next,j); SBAR(); } }while(0)
  #define STEP(C0,C1,P0,P1,t,GK,GV,GL) do{ SBAR(); \
    const lds_cptr vp_=vp0+sl_prev; \
    VRD(0); SBAR(); float sacc=(P0[0]+P0[1]); \
    GAPA(C0=__builtin_amdgcn_mfma_f32_32x32x16_bf16(kf[0],qr[0],negm,0,0,0), P0[2],P0[3],P0[4],P0[5],     pw0[0]=PKW(P0,0), pw0[1]=PKW(P0,2), pw0); \
    VRD(4); SBAR(); GAPA(C1=__builtin_amdgcn_mfma_f32_32x32x16_bf16(kf[1],qr[0],negm,0,0,0), P0[6],P0[7],P0[8],P0[9],     pw0[2]=PKW(P0,4), pw0[3]=PKW(P0,6), pw0); \
    VRD(1); SBAR(); GAPA(C0=__builtin_amdgcn_mfma_f32_32x32x16_bf16(kf[2],qr[1],C0,0,0,0),   P0[10],P0[11],P0[12],P0[13], pw1[0]=PKW(P0,8), pw1[1]=PKW(P0,10), pw1); \
    VRD(5); SBAR(); GAPA(C1=__builtin_amdgcn_mfma_f32_32x32x16_bf16(kf[3],qr[1],C1,0,0,0),   P0[14],P0[15],P1[0],P1[1],   pw1[2]=PKW(P0,12),pw1[3]=PKW(P0,14), pw1); \
    VRD(2); SBAR(); GAPA(C0=__builtin_amdgcn_mfma_f32_32x32x16_bf16(kf[4],qr[2],C0,0,0,0),   P1[2],P1[3],P1[4],P1[5],     pw2[0]=PKW(P1,0), pw2[1]=PKW(P1,2), pw2); \
    VRD(6); SBAR(); GAPA(C1=__builtin_amdgcn_mfma_f32_32x32x16_bf16(kf[5],qr[2],C1,0,0,0),   P1[6],P1[7],P1[8],P1[9],     pw2[2]=PKW(P1,4), pw2[3]=PKW(P1,6), pw2); \
    VRD(3); SBAR(); GAPA(C0=__builtin_amdgcn_mfma_f32_32x32x16_bf16(kf[6],qr[3],C0,0,0,0),   P1[10],P1[11],P1[12],P1[13], pw3[0]=PKW(P1,8), pw3[1]=PKW(P1,10), pw3); \
    VRD(7); SBAR(); GAPA(C1=__builtin_amdgcn_mfma_f32_32x32x16_bf16(kf[7],qr[3],C1,0,0,0),   P1[14],P1[15],0.f,0.f,       pw3[2]=PKW(P1,12),pw3[3]=PKW(P1,14), pw3); \
    l_reg+=sacc; \
    if(GK){DMA_K((t)+3,sl_cur);} if(GV){DMA_V((t)+1,sl_next);} \
    CMASK(C0,C1,t); \
    { float a=MX3(C0[0],C0[1],C1[0]),b=MX3(C0[2],C0[3],C1[1]); a=MX3(a,C1[2],C1[3]); \
      _Pragma("unroll") for(int r=4;r<16;r+=4){a=MX3(a,C0[r],C0[r+1]);b=MX3(b,C0[r+2],C0[r+3]);a=MX3(a,C1[r],C1[r+1]);b=MX3(b,C1[r+2],C1[r+3]);} \
      float rm=__builtin_fmaxf(a,b); { auto rr=__builtin_amdgcn_permlane32_swap(__float_as_uint(rm),__float_as_uint(rm),false,false); rm=__builtin_fmaxf(__uint_as_float(rr[0]),__uint_as_float(rr[1])); } \
      resc=false; \
      if(__builtin_expect(__any(rm>(float)THRL),0)){ const float dl=__builtin_fmaxf(rm,0.f); mhat+=dl; \
        _Pragma("unroll") for(int r=0;r<16;++r){C0[r]-=dl;C1[r]-=dl;} \
        _Pragma("unroll") for(int r=0;r<16;++r)negm[r]=-mhat; asm volatile("":"+v"(negm)); \
        const float f=__builtin_amdgcn_exp2f(-dl); l_reg*=f; if(hi==0)wsf[r32]=f; resc=true; } } \
    SBAR(); \
    GAPB(o[0]=__builtin_amdgcn_mfma_f32_32x32x16_bf16(PAF(0),VFR(0),o[0],0,0,0), C0,0); \
    GAPB(o[1]=__builtin_amdgcn_mfma_f32_32x32x16_bf16(PAF(0),VFR(4),o[1],0,0,0), C0,4); \
    KRD(GL,0); GAPB(o[0]=__builtin_amdgcn_mfma_f32_32x32x16_bf16(PAF(1),VFR(1),o[0],0,0,0), C0,8); \
    KRD(GL,1); GAPB(o[1]=__builtin_amdgcn_mfma_f32_32x32x16_bf16(PAF(1),VFR(5),o[1],0,0,0), C0,12); \
    KRD(GL,2); GAPB(o[0]=__builtin_amdgcn_mfma_f32_32x32x16_bf16(PAF(2),VFR(2),o[0],0,0,0), C1,0); \
    KRD(GL,3); GAPB(o[1]=__builtin_amdgcn_mfma_f32_32x32x16_bf16(PAF(2),VFR(6),o[1],0,0,0), C1,4); \
    GAPB(o[0]=__builtin_amdgcn_mfma_f32_32x32x16_bf16(PAF(3),VFR(3),o[0],0,0,0), C1,8); \
    GAPB(o[1]=__builtin_amdgcn_mfma_f32_32x32x16_bf16(PAF(3),VFR(7),o[1],0,0,0), C1,12); \
    }while(0)
  int t=1;
  for(;t+5<NT;t+=2){
    STEP(pB0,pB1,pA0,pA1,t,true,true,true);     WAIT_BAR(2); RESC(); ROT();
    STEP(pA0,pA1,pB0,pB1,t+1,true,true,true);   WAIT_BAR(2); RESC(); ROT();
  }
  #define ENDW(tt) do{ if((tt)+3<NT){WAIT_BAR(2);} else if((tt)+2<NT){WAIT_BAR(1);} else {WAIT_BAR(0);} }while(0)
  for(;t+1<NT;t+=2){
    STEP(pB0,pB1,pA0,pA1,t,(t+3<NT),(t+1<NT),(t+1<NT));       ENDW(t);   RESC(); ROT();
    STEP(pA0,pA1,pB0,pB1,t+1,(t+4<NT),(t+2<NT),(t+2<NT));     ENDW(t+1); RESC(); ROT();
  }
  STEP(pB0,pB1,pA0,pA1,NT-1,false,false,false); RESC();
  { float sacc=pB0[0]+pB0[1]; _Pragma("unroll") for(int r=2;r<16;++r)sacc+=pB0[r]; _Pragma("unroll") for(int r=0;r<16;++r)sacc+=pB1[r]; l_reg+=sacc;
    pw0=(u32x4){PKW(pB0,0),PKW(pB0,2),PKW(pB0,4),PKW(pB0,6)};pw1=(u32x4){PKW(pB0,8),PKW(pB0,10),PKW(pB0,12),PKW(pB0,14)};pw2=(u32x4){PKW(pB1,0),PKW(pB1,2),PKW(pB1,4),PKW(pB1,6)};pw3=(u32x4){PKW(pB1,8),PKW(pB1,10),PKW(pB1,12),PKW(pB1,14)};
    SBAR(); pv(o,vb0+sl_cur,PAF(0),PAF(1),PAF(2),PAF(3)); }
  #undef PKW
  #undef PAF
  #undef VFR
  #undef PIN
  #undef MX3
  #undef GAPA
  #undef GAPB
  #undef EX
  #undef VRD
  #undef KRD
  #undef STEP
  #undef ENDW
  {auto rr=__builtin_amdgcn_permlane32_swap(__float_as_uint(l_reg),__float_as_uint(l_reg),false,false);l_reg=__uint_as_float(rr[0])+__uint_as_float(rr[1]);}
  const float lse_own=mhat+__log2f(l_reg);
  const AttnBack B=back();
  if(hi==0){wsf[32+r32]=l_reg;wsf[r32]=lse_own;}
  asm volatile("s_waitcnt lgkmcnt(0)":::"memory");
  if(B.mode==1&&hi==0)B.lse[(long)(q0+wid*QBLK+r32)*B.lstride]=lse_own;
  float rli[16];
  #pragma unroll
  for(int r=0;r<16;++r)rli[r]=__builtin_amdgcn_rcpf(wsf[32+crow(r,hi)]);
  bf16*Ow=B.O+(long)(q0+wid*QBLK)*B.ostride;
  { bf16*stg=(bf16*)(shm+LDS_OST)+wid*2048;
    #pragma unroll
    for(int r=0;r<16;++r){const int orow=crow(r,hi);
      #pragma unroll
      for(int d0=0;d0<2;++d0)stg[orow*64+d0*32+r32]=__float2bfloat16(o[d0][r]*rli[r]);}
    asm volatile("s_waitcnt lgkmcnt(0)":::"memory");
    #pragma unroll
    for(int i=0;i<4;++i){const int row=i*8+(lane>>3),ch=lane&7; u32x4 v=*(const u32x4*)(stg+row*64+ch*8);
      if(B.mode==2){ const int pos=q0+wid*QBLK+row; const float l1=wsf[row],l4=((const float*)(B.ws+WS_LSE4))[B.lse_off+pos],l16=((const float*)(B.ws+WS_LSE16))[B.lse_off+pos];
        const float mx=fmaxf(l1,fmaxf(l4,l16)); float w1=__builtin_amdgcn_exp2f(l1-mx),w4=__builtin_amdgcn_exp2f(l4-mx),w16=__builtin_amdgcn_exp2f(l16-mx);
        const float inv=1.0f/(w1+w4+w16); w1*=inv; w4*=inv; w16*=inv;
        const u32x4 a4=*(const u32x4*)((const bf16*)(B.ws+WS_OB4)+B.mrg_off+(long)pos*768+ch*8), a16=*(const u32x4*)((const bf16*)(B.ws+WS_OB16)+B.mrg_off+(long)pos*768+ch*8);
        #pragma unroll
        for(int e=0;e<4;++e){
          const float lo=w1*__uint_as_float(v[e]<<16)+w4*__uint_as_float(a4[e]<<16)+w16*__uint_as_float(a16[e]<<16);
          const float hh=w1*__uint_as_float(v[e]&0xffff0000u)+w4*__uint_as_float(a4[e]&0xffff0000u)+w16*__uint_as_float(a16[e]&0xffff0000u);
          v[e]=cvtpk_s(lo,hh);} }
      ATTN_STORE16(Ow+(long)row*B.ostride+ch*8,v);} }
  asm volatile("s_waitcnt lgkmcnt(0)\n\ts_barrier":::"memory");
  #undef DMA_K
  #undef DMA_V
  #undef CMASK
  #undef START
  #undef RESC
  #undef ROT
}
__device__ __forceinline__ void fox_scan(const float*fl,char*shm){
  const int tid=opaque_tid(),lane=tid&63,wid=tid>>6;
  const f32x4a a=((const f32x4a*)fl)[2*tid],b=((const f32x4a*)fl)[2*tid+1];
  float v[8]={a[0],a[1],a[2],a[3],b[0],b[1],b[2],b[3]};
  #pragma unroll
  for(int i=1;i<8;++i)v[i]+=v[i-1];
  float incl=v[7];
  #pragma unroll
  for(int o=1;o<64;o<<=1){const float t=__shfl_up(incl,o);if(lane>=o)incl+=t;}
  const float excl=incl-v[7];
  float*wt=(float*)(shm+LDS_CS+16384);
  if(lane==63)wt[wid]=incl;
  __syncthreads();
  float base=excl;
  for(int w=0;w<wid;++w)base+=wt[w];
  const float L2E=1.4426950408889634f;
  f32x4a o0,o1;
  #pragma unroll
  for(int i=0;i<4;++i){o0[i]=(base+v[i])*L2E;o1[i]=(base+v[4+i])*L2E;}
  f32x4a*cs=(f32x4a*)(shm+LDS_CS);
  cs[2*tid]=o0;cs[2*tid+1]=o1;
  __syncthreads();
}
#undef SBAR
#undef WAIT_BAR
}

constexpr int LDSCTL_OFF = 0, LDSCTL_BYTES = 2048, MISC_OFF = LDSCTL_OFF + 320;
constexpr int RING_OFF = LDSCTL_BYTES, RING_BYTES = 131072;
constexpr int LDS_BYTES = 147456;
static_assert(attn_body::LDS_CS + 16384 + 64 <= RING_BYTES && RING_OFF + RING_BYTES <= LDS_BYTES, "LDS map");

#define GAS __attribute__((address_space(1)))
#define LAS __attribute__((address_space(3)))
typedef unsigned short bf16;
typedef unsigned v4u __attribute__((ext_vector_type(4)));
typedef float f32x4 __attribute__((ext_vector_type(4)));
typedef short bf16x8 __attribute__((ext_vector_type(8)));
typedef GAS unsigned gu32;
typedef GAS unsigned long long gu64;
#define RLX_AGENT __ATOMIC_RELAXED, __HIP_MEMORY_SCOPE_AGENT
#define LDS_WAIT() asm volatile("s_waitcnt lgkmcnt(0)" ::: "memory")
#define VM_WAIT() asm volatile("s_waitcnt vmcnt(0)" ::: "memory")
__device__ __forceinline__ unsigned long long rt() { return __builtin_amdgcn_s_memrealtime(); }
__device__ __forceinline__ unsigned f2bf(float f) { unsigned u = __builtin_bit_cast(unsigned, f); return (u + 0x7fffu + ((u >> 16) & 1u)) >> 16; }
__device__ __forceinline__ unsigned pk2(float lo, float hi) { return f2bf(lo) | (f2bf(hi) << 16); }

#define XB_TMO      128
#define XB_XCNT(j)  (256  + 64 * (j))
#define XB_XSUB(j)  (1280 + 64 * (j))
#define XB_XGEN(j)  (2304 + 64 * (j))
#define XB_TOP      3328
#define XB_TOPGEN   3392
#define XCD_BAR_WORDS 3456
#define XB_SPIN_CAP (1u << 18)

__device__ __forceinline__ unsigned xb_ld(unsigned* p)              { return __hip_atomic_load(p, __ATOMIC_RELAXED, __HIP_MEMORY_SCOPE_AGENT); }
__device__ __forceinline__ unsigned xb_add(unsigned* p, unsigned v) { return __hip_atomic_fetch_add(p, v, __ATOMIC_RELAXED, __HIP_MEMORY_SCOPE_AGENT); }
__device__ __forceinline__ unsigned xb_xcc_id() { return (unsigned)__builtin_amdgcn_s_getreg((3 << 11) | 20) & 0xFu; }
#define XB_SPIN(cond, bar) do { unsigned _sp = 0; while (cond) { __builtin_amdgcn_s_sleep(1); \
    if ((++_sp & 255u) == 0u) { if (xb_ld(&(bar)[XB_TMO])) break; if (_sp > XB_SPIN_CAP) { atomicAdd(&(bar)[XB_TMO], 1u); break; } } } } while (0)

struct XcdBarrier {
    unsigned* bar; unsigned x;
    volatile LAS unsigned* st;
};

__device__ __forceinline__ XcdBarrier xcd_barrier_post(unsigned* bar, volatile LAS unsigned* st) {
    XcdBarrier b; b.bar = bar; b.x = xb_xcc_id(); b.st = st;
    if (threadIdx.x == 0) (void)xb_add(&bar[XB_XCNT(b.x)], 1u);
    return b;
}
__device__ __forceinline__ void xcd_barrier_complete(unsigned* bar, unsigned x, unsigned& nloc, unsigned& nx) {
    const unsigned G = gridDim.x * gridDim.y * gridDim.z;
    unsigned sum, cnt, mine, sp = 0u;
    for (;;) {
        sum = 0u; cnt = 0u; mine = 0u;
#pragma unroll
        for (unsigned j = 0; j < 16; ++j) { const unsigned c = xb_ld(&bar[XB_XCNT(j)]); sum += c; cnt += (c > 0u) ? 1u : 0u; mine = (j == x) ? c : mine; }
        if (sum == G) break;
        __builtin_amdgcn_s_sleep(1);
        if ((++sp & 255u) == 0u) { if (xb_ld(&bar[XB_TMO])) break; if (sp > XB_SPIN_CAP) { atomicAdd(&bar[XB_TMO], 1u); break; } }
    }
    nloc = mine > 0u ? mine : 1u; nx = cnt > 0u ? cnt : 1u;
}

__device__ __forceinline__ void xcd_barrier(const XcdBarrier& b) {
    asm volatile("s_waitcnt vmcnt(0)" ::: "memory");
    __syncthreads();
    if (threadIdx.x == 0) {
        unsigned* bar = b.bar;
        __builtin_amdgcn_s_waitcnt(0);
        unsigned nloc = b.st[0], nx = b.st[1];
        if (nloc == 0u) { xcd_barrier_complete(bar, b.x, nloc, nx); b.st[0] = nloc; b.st[1] = nx; }
        const unsigned old = xb_add(&bar[XB_XSUB(b.x)], 1u);
        const unsigned gen = old / nloc;
        if (old + 1u == (gen + 1u) * nloc) {
            __builtin_amdgcn_fence(__ATOMIC_RELEASE, "agent");
            asm volatile("s_waitcnt vmcnt(0)" ::: "memory");
            const unsigned og = xb_add(&bar[XB_TOP], 1u);
            const unsigned tg = og / nx;
            if (og + 1u == (tg + 1u) * nx) xb_add(&bar[XB_TOPGEN], 1u);
            else XB_SPIN(xb_ld(&bar[XB_TOPGEN]) == tg, bar);
            __builtin_amdgcn_fence(__ATOMIC_ACQUIRE, "agent");
            xb_add(&bar[XB_XGEN(b.x)], 1u);
            asm volatile("s_waitcnt vmcnt(0)" ::: "memory");
        } else {
            XB_SPIN(xb_ld(&bar[XB_XGEN(b.x)]) == gen, bar);
            __builtin_amdgcn_fence(__ATOMIC_ACQUIRE, "agent");
            asm volatile("s_waitcnt vmcnt(0)" ::: "memory");
        }
    }
    __syncthreads();
}

struct Frame {
    LAS unsigned char* lds;
    volatile LAS unsigned* MISC;
    gu32* ctl;
    int tid, lane, wave, vcu;
};
__device__ __forceinline__ void frame_refresh(Frame& F, unsigned char* ldsarr) {
    F.lds = (LAS unsigned char*)ldsarr + opaque_zero(); F.tid = opaque_tid(); F.lane = F.tid & 63; F.wave = __builtin_amdgcn_readfirstlane(F.tid >> 6);
}
__device__ __forceinline__ float wave_sum(float v) {
#pragma unroll
    for (int o = 1; o < 64; o <<= 1) v += __shfl_xor(v, o);
    return v;
}
enum { CM_ID = 0, CM_FOX = 1, CM_DIL = 2, CM_UP = 3 };
__device__ __forceinline__ int rope_perm(int j) { return (j & 1) ? 32 + (j >> 1) : (j >> 1); }
__device__ __forceinline__ int colmap(int kind, int n) {
    if (kind == CM_ID) return n;
    if (kind == CM_UP) { const int pn = n >> 8, bj = (n >> 7) & 1, j = n & 127; return bj * FFD + 128 * pn + j; }
    if (kind == CM_FOX) { if (n < 768) return n; if (n < 1024) return 2316 + (n - 768); if (n < 1792) return 768 + (n - 1024); if (n < 2560) return 1536 + (n - 1792); if (n < 2572) return 2304 + (n - 2560); return -1; }
    if (n < 768) return (n & ~63) + rope_perm(n & 63);
    if (n < 1024) return 2304 + (n - 768);
    if (n < 1792) { const int k = n - 1024; return 768 + (k & ~63) + rope_perm(k & 63); }
    return 1536 + (n - 1792);
}
__device__ __forceinline__ f32x4 conv_load4(const float* wrow, int kind, int n4) {
    if (kind == CM_DIL && n4 < 1792 && !(n4 >= 768 && n4 < 1024)) {
        const int k = n4 < 768 ? n4 : n4 - 1024, hb = (n4 < 768 ? 0 : 768) + (k & ~63), m2 = (k & 63) >> 1;
        typedef float f32x2 __attribute__((ext_vector_type(2)));
        const f32x2 a = *(const GAS f32x2*)(wrow + hb + m2), b = *(const GAS f32x2*)(wrow + hb + 32 + m2);
        return (f32x4){a.x, b.x, a.y, b.y};
    }
    const int sc = colmap(kind, n4);
    if (sc < 0) return (f32x4){0.f, 0.f, 0.f, 0.f};
    return *(const GAS f32x4*)(wrow + sc);
}
__device__ __forceinline__ void transpose_item(const float* W, int K, int Nsrc, bf16* WT, const float* g, int kind, int kb, int nb, int lane) {
    const int kg = lane & 7, ng = lane >> 3, k0 = 64 * kb + 8 * kg, n4 = 32 * nb + 4 * ng;
    f32x4 v[8];
#pragma unroll
    for (int j = 0; j < 8; ++j) v[j] = conv_load4(W + (size_t)(k0 + j) * Nsrc, kind, n4);
    if (g) { const f32x4 g0 = *(const GAS f32x4*)(g + k0), g1 = *(const GAS f32x4*)(g + k0 + 4);
        v[0] = v[0] * g0.x; v[1] = v[1] * g0.y; v[2] = v[2] * g0.z; v[3] = v[3] * g0.w; v[4] = v[4] * g1.x; v[5] = v[5] * g1.y; v[6] = v[6] * g1.z; v[7] = v[7] * g1.w; }
#pragma unroll
    for (int e = 0; e < 4; ++e) { v4u o; o.x = pk2(v[0][e], v[1][e]); o.y = pk2(v[2][e], v[3][e]); o.z = pk2(v[4][e], v[5][e]); o.w = pk2(v[6][e], v[7][e]);
        *(GAS v4u*)(WT + (size_t)(n4 + e) * K + k0) = o; }
}
__device__ __forceinline__ void convert_matrix(Frame& F, const float* W, int K, int Nsrc, bf16* WT, int Ndst, const float* g, int kind) {
    const int gw = F.vcu * NWAVES + F.wave, NGW = GRID * NWAVES, nblk = Ndst / 32, nitems = (K / 64) * nblk;
    for (int it = gw; it < nitems; it += NGW) transpose_item(W, K, Nsrc, WT, g, kind, it / nblk, it % nblk, F.lane);
}

constexpr int PT_OFF = LDSCTL_OFF + 1024;   static_assert(PT_OFF + 17 * 8 <= LDSCTL_BYTES && MISC_OFF + 128 <= PT_OFF, "LDS control map");
enum { PT_X = 0, PT_MEM, PT_NMIX, PT_NMEM, PT_NFFN, PT_WFOX, PT_BFOR, PT_WDIL, PT_WMKV, PT_WOUT, PT_WUP, PT_CW, PT_CB, PT_WDN, PT_NFIN, PT_OUT, PT_WS };
__device__ __forceinline__ GAS unsigned char* ldptr(LAS unsigned char* lds, int i) {
    volatile LAS unsigned* p = (volatile LAS unsigned*)(lds + PT_OFF) + 2 * i;
    const unsigned lo = __builtin_amdgcn_readfirstlane(p[0]), hi = __builtin_amdgcn_readfirstlane(p[1]);
    return (GAS unsigned char*)(((unsigned long long)hi << 32) | lo);
}
#define PTR_F(i) ((const float*)(unsigned char*)ldptr(F.lds, (i)))
struct UnitKey { int kind, i, layer, v; };
__device__ __forceinline__ void attn_make(const UnitKey& key, const unsigned char* ws, attn_body::AttnDesc& U, attn_body::AttnBack& B, int& bh) {
    typedef attn_body::bf16 abf;
    const int kind = key.kind, i = key.i, layer = key.layer, v = key.v;
    bh = 0;
    U.fox = 0; U.qadd = 0; U.W = 128; U.t_lo = 0; U.NT = 4; U.q0 = 0;
    B.ws = ws; B.mode = 0; B.lse = nullptr; B.lstride = 0; B.mrg_off = 0; B.lse_off = 0;
    const abf* QOa = (const abf*)(ws + WS_QO); const abf* KBa = (const abf*)(ws + WS_K); const abf* VBa = (const abf*)(ws + WS_V);
    if ((kind != 1) && i == 3) {
        const int b = v >> 6, hm = (v >> 4) & 3, qb = v & 15;
        U.Q = QOa + (size_t)(b * SEQ) * 1024 + (12 + hm) * 64; B.O = (abf*)U.Q; U.qstride = 1024; B.ostride = 1024;
        U.K = (const abf*)(ws + WS_KVM) + (size_t)(b * MEMT) * 2048 + 512 * layer + 64 * hm; U.V = U.K + 256; U.kstride = 2048;
        U.q0 = 256 * qb; U.W = 0x7fffffff; U.qadd = 1 << 20;
    } else if (kind == 0) {
        const int g = v >> 4, ii = v & 15; bh = 3 * g + i; const int qb = i == 0 ? ii : (i == 1 ? ((ii + 8) & 15) : (ii < 8 ? 15 - 2 * ii : 30 - 2 * ii));
        const int b = bh / NMIX, h = bh % NMIX;
        U.Q = QOa + (size_t)(b * SEQ) * 1024 + h * 64; B.O = (abf*)U.Q; U.qstride = 1024; B.ostride = 1024;
        U.K = KBa + (size_t)(b * SEQ) * 768 + h * 64; U.V = VBa + (size_t)(b * SEQ) * 768 + h * 64; U.kstride = 768;
        U.q0 = 256 * qb; U.NT = 4 * qb + 4; U.W = 0x7fffffff; U.fox = 1;
    } else if (kind == 1 && i < 3) {
        const int e = v + 256 * i, r = e & 15; bh = e >> 4; const int b = bh / NMIX, h = bh % NMIX;
        U.Q = QOa + (size_t)(b * SEQ + r) * 1024 + h * 64; U.qstride = 16 * 1024;
        B.O = (abf*)(ws + WS_OB16) + (size_t)(b * SEQ + r) * 768 + h * 64; B.ostride = 16 * 768;
        U.K = KBa + (size_t)(b * SEQ + r) * 768 + h * 64; U.V = VBa + (size_t)(b * SEQ + r) * 768 + h * 64; U.kstride = 16 * 768;
        B.mode = 1; B.lse = (float*)(ws + WS_LSE16) + (size_t)bh * SEQ + r; B.lstride = 16;
    } else if (kind == 1) {
        const int k = i - 3, e = v + 256 * k, qb = ((v & 3) + k) & 3, rest = e >> 2, r = rest & 3; bh = rest >> 2; const int b = bh / NMIX, h = bh % NMIX;
        U.Q = QOa + (size_t)(b * SEQ + r) * 1024 + h * 64; U.qstride = 4 * 1024;
        B.O = (abf*)(ws + WS_OB4) + (size_t)(b * SEQ + r) * 768 + h * 64; B.ostride = 4 * 768;
        U.K = KBa + (size_t)(b * SEQ + r) * 768 + h * 64; U.V = VBa + (size_t)(b * SEQ + r) * 768 + h * 64; U.kstride = 4 * 768;
        U.q0 = 256 * qb; U.t_lo = qb ? 4 * qb - 2 : 0; U.NT = qb ? 6 : 4;
        B.mode = 1; B.lse = (float*)(ws + WS_LSE4) + (size_t)bh * SEQ + r; B.lstride = 4;
    } else {
        const int e = v + 256 * i, qb = e & 15; bh = e >> 4; const int b = bh / NMIX, h = bh % NMIX;
        U.Q = QOa + (size_t)(b * SEQ) * 1024 + h * 64; B.O = (abf*)U.Q; U.qstride = 1024; B.ostride = 1024;
        U.K = KBa + (size_t)(b * SEQ) * 768 + h * 64; U.V = VBa + (size_t)(b * SEQ) * 768 + h * 64; U.kstride = 768;
        U.q0 = 256 * qb; U.t_lo = qb ? 4 * qb - 2 : 0; U.NT = qb ? 6 : 4;
        B.mode = 2; B.mrg_off = (b * SEQ) * 768 + h * 64; B.lse_off = bh * SEQ;
    }
}
struct AttnBackFn { UnitKey key; LAS unsigned char* lds;
    __device__ __forceinline__ attn_body::AttnBack operator()() const { attn_body::AttnDesc U; attn_body::AttnBack B; int bh; attn_make(key, (const unsigned char*)ldptr(lds, PT_WS), U, B, bh); return B; }
};
struct Args { const float* in[15]; float* out; unsigned char* ws; };
__global__ void __launch_bounds__(NWAVES * 64, 2) mk_fwd(Args args) {
    extern __shared__ __attribute__((aligned(16))) unsigned char lds[];
    Frame F;
    F.lds = (LAS unsigned char*)lds;
    F.MISC = (volatile LAS unsigned*)(F.lds + MISC_OFF);
    F.tid = threadIdx.x; F.lane = F.tid & 63; F.wave = __builtin_amdgcn_readfirstlane(F.tid >> 6);
    { const int bx = blockIdx.x; F.vcu = (bx % 8) * (GRID / 8) + bx / 8; }
    F.ctl = (gu32*)(args.ws + WS_CTL);
    for (int u = F.tid; u < LDSCTL_BYTES / 4; u += NWAVES * 64) ((LAS unsigned*)(F.lds + LDSCTL_OFF))[u] = 0u;
    __syncthreads();
    if (F.tid == 0) { LAS unsigned long long* pt = (LAS unsigned long long*)(F.lds + PT_OFF);
#pragma unroll
        for (int i = 0; i < 15; ++i) pt[i] = (unsigned long long)args.in[i];
        pt[PT_OUT] = (unsigned long long)args.out; pt[PT_WS] = (unsigned long long)args.ws; }
    __syncthreads();
    XcdBarrier bar = xcd_barrier_post((unsigned*)(F.ctl + CW_BAR), F.MISC + 8);
#define GRID_BAR() do { XcdBarrier b_ = bar; b_.bar += opaque_zero(); b_.x += (unsigned)opaque_zero(); xcd_barrier(b_); } while (0)

#ifdef PROBE
    int n_stamp = 0;
#define STAMP() do { if (blockIdx.x == 0 && threadIdx.x == 0) ((GAS unsigned long long*)(bar.bar - CW_BAR + 131072))[n_stamp] = __builtin_amdgcn_s_memrealtime(); ++n_stamp; } while (0)
#else
#define STAMP() do {} while (0)
#endif
#ifdef PROBE
#define STAMP2(k) do { if (blockIdx.x == 0 && threadIdx.x == 0) ((GAS unsigned long long*)(bar.bar - CW_BAR + 131072))[k] = __builtin_amdgcn_s_memrealtime(); } while (0)
#else
#define STAMP2(k) do {} while (0)
#endif
    STAMP();
    {
        frame_refresh(F, lds); unsigned char* ws = (unsigned char*)ldptr(F.lds, PT_WS);
        const int gw = F.vcu * NWAVES + F.wave, NGW = GRID * NWAVES, gtid = F.vcu * (NWAVES * 64) + F.tid, NGT = GRID * NWAVES * 64;
#pragma nounroll
        for (int l = 0; l < DEPTH; ++l) {
            bf16* win = (bf16*)(ws + WS_WIN + (size_t)l * WIN_STRIDE);
            if (l & 1) convert_matrix(F, PTR_F(PT_WDIL) + (size_t)(l >> 1) * DMODEL * DIL_IN, DMODEL, DIL_IN, win, 2560, PTR_F(PT_NMIX) + l * DMODEL, CM_DIL);
            else convert_matrix(F, PTR_F(PT_WFOX) + (size_t)(l >> 1) * DMODEL * FOX_IN, DMODEL, FOX_IN, win, 2816, PTR_F(PT_NMIX) + l * DMODEL, CM_FOX);
            convert_matrix(F, PTR_F(PT_WOUT) + (size_t)l * DMODEL * DMODEL, DMODEL, DMODEL, (bf16*)(ws + WS_WOUT + (size_t)l * WOUT_STRIDE), 1024, nullptr, CM_ID);
            convert_matrix(F, PTR_F(PT_WMKV) + (size_t)l * DMODEL * 512, DMODEL, 512, (bf16*)(ws + WS_WMKV) + (size_t)l * 512 * DMODEL, 512, PTR_F(PT_NMEM) + l * DMODEL, CM_ID);
        }
        STAMP2(101);
        {
            const float* x = PTR_F(PT_X); float* hres = (float*)(unsigned char*)ldptr(F.lds, PT_OUT); bf16* hb = (bf16*)(ws + WS_HB); float* ssqA = (float*)(ws + WS_SSQA);
            for (int m = gw; m < MTOK; m += NGW) {
                const GAS f32x4* xr = (const GAS f32x4*)(x + (size_t)m * DMODEL) + F.lane; GAS f32x4* hr = (GAS f32x4*)(hres + (size_t)m * DMODEL) + F.lane;
                GAS unsigned long long* o8 = (GAS unsigned long long*)(hb + (size_t)(m + 2) * DMODEL) + F.lane;
                float s = 0.f;
#pragma unroll
                for (int j = 0; j < 4; ++j) { const f32x4 v = xr[64 * j]; s += (v.x * v.x + v.y * v.y) + (v.z * v.z + v.w * v.w); hr[64 * j] = v;
                    o8[64 * j] = (unsigned long long)pk2(v.x, v.y) | ((unsigned long long)pk2(v.z, v.w) << 32); }
                s = wave_sum(s);
                if (F.lane == 0) { ssqA[m] = s; ssqA[MTOK + m] = 0.f; ssqA[2 * MTOK + m] = 0.f; ssqA[3 * MTOK + m] = 0.f; }
            }
            for (int idx = gtid; idx < 258 * 128; idx += NGT) { const int r = idx >> 7, c = idx & 127; const int row = r < 2 ? r : MTOK + r; *(GAS v4u*)(hb + (size_t)row * DMODEL + c * 8) = (v4u){0u, 0u, 0u, 0u}; }
        }
        STAMP2(102);
        {
            const float* mem = PTR_F(PT_MEM); bf16* memb = (bf16*)(ws + WS_MEMB); float* rmem = (float*)(ws + WS_RMEM);
            for (int m = gw; m < BATCH * MEMT; m += NGW) {
                const GAS f32x4* xr = (const GAS f32x4*)(mem + (size_t)m * DMODEL) + F.lane; GAS unsigned long long* o8 = (GAS unsigned long long*)(memb + (size_t)m * DMODEL) + F.lane;
                float s = 0.f;
#pragma unroll
                for (int j = 0; j < 4; ++j) { const f32x4 v = xr[64 * j]; s += (v.x * v.x + v.y * v.y) + (v.z * v.z + v.w * v.w);
                    o8[64 * j] = (unsigned long long)pk2(v.x, v.y) | ((unsigned long long)pk2(v.z, v.w) << 32); }
                s = wave_sum(s);
                if (F.lane == 0) rmem[m] = 1.0f / sqrtf(s * (1.0f / DMODEL) + 1e-6f);
            }
        }
        STAMP2(103);
        {
            float* rope = (float*)(ws + WS_ROPE);
            for (int idx = gtid; idx < SEQ * 32; idx += NGT) { const int pos = idx >> 5, i = idx & 31;
                const float inv = (float)exp(-(double)(2 * i) / 64.0 * 9.210340371976184); const float ang = (float)pos * inv; float sn, cs; sincosf(ang, &sn, &cs);
                rope[idx] = cs; rope[SEQ * 32 + idx] = sn; }
        }
    }
    STAMP2(104);
    GRID_BAR(); STAMP();

#pragma nounroll
    for (int layer = 0; layer < DEPTH; ++layer) {
        const int dil = layer & 1, slot = layer >> 1;
        {
            frame_refresh(F, lds); unsigned char* ws = (unsigned char*)ldptr(F.lds, PT_WS);
            pg8::Gemm g{(const pg8::bf16_t*)(ws + WS_HB) + 2 * DMODEL, (const pg8::bf16_t*)(ws + WS_WIN + (size_t)layer * WIN_STRIDE), DMODEL, 0};
            pg8::StaticOrder S; S.init(64, dil ? 10 : 11, GRID, (int)blockIdx.x);
            pg8::EpiInProj E{(pg8::bf16_t*)(ws + WS_QO), (pg8::bf16_t*)(ws + WS_K), (pg8::bf16_t*)(ws + WS_V), (float*)(ws + WS_FLOG), (const float*)(ws + WS_SSQA), PTR_F(PT_BFOR) + slot * NMIX, (const float*)(ws + WS_ROPE), dil, dil ? nullptr : (unsigned*)(ws + WS_CTL) + CW_NRM + slot * 192};
#ifndef NO_INPROJ
            pg8::gemm_phase<pg8::EpiInProj, pg8::StaticOrder, PG8_ALIGN, PG8_SP2>(F.lds + RING_OFF, g, S, E);
#endif
        }
        if (layer == 0) {
            frame_refresh(F, lds); unsigned char* ws = (unsigned char*)ldptr(F.lds, PT_WS);
            pg8::Gemm g2{(const pg8::bf16_t*)(ws + WS_MEMB), (const pg8::bf16_t*)(ws + WS_WMKV), DMODEL, 0};
            pg8::StaticOrder S2; S2.init(4, 8, GRID, ((int)blockIdx.x + 64) & 255);
            pg8::EpiMemKV E2{(pg8::bf16_t*)(ws + WS_KVM), (const float*)(ws + WS_RMEM)};
#ifndef NO_MEMKV
            pg8::gemm_phase<pg8::EpiMemKV, pg8::StaticOrder, PG8_ALIGN, PG8_SP2>(F.lds + RING_OFF, g2, S2, E2);
#endif
        }
        GRID_BAR(); STAMP();
        {
            frame_refresh(F, lds); unsigned char* ws = (unsigned char*)ldptr(F.lds, PT_WS);
            convert_matrix(F, PTR_F(PT_WUP) + (size_t)layer * DMODEL * FF2, DMODEL, FF2, (bf16*)(ws + WS_WUP), FF2, PTR_F(PT_NFFN) + layer * DMODEL, CM_UP);
            convert_matrix(F, PTR_F(PT_WDN) + (size_t)layer * FFD * DMODEL, FFD, DMODEL, (bf16*)(ws + WS_WDN), DMODEL, nullptr, CM_ID);
        }
        __syncthreads();
        if (layer < 2) STAMP2(110 + 20 * layer);
#pragma nounroll
        for (int sub = 0; sub < 1 + dil; ++sub) {
            const int kind = dil ? 1 + sub : 0;
            const int nun = kind == 1 ? 6 : 4;
#pragma nounroll
            for (int i = 0; i < nun; ++i) {
                frame_refresh(F, lds);
                const UnitKey key{kind, i, layer, F.vcu};
                attn_body::AttnDesc U; attn_body::AttnBack Bdummy; int bh = 0;
                { const unsigned char* ws = (unsigned char*)ldptr(F.lds, PT_WS); attn_make(key, ws, U, Bdummy, bh);
                  if (U.fox) { attn_body::fox_scan((const float*)(ws + WS_FLOG) + (size_t)bh * SEQ, (char*)F.lds + RING_OFF);
                      const GAS unsigned* nr = (const GAS unsigned*)(ws + WS_CTL) + CW_NRM + (layer >> 1) * 192 + bh * 4;
                      const float qn2 = __uint_as_float(nr[0]) + __uint_as_float(nr[1]), kn2 = __uint_as_float(nr[2]) + __uint_as_float(nr[3]);
                      const float theta = 40.0f + 2.02f * sqrtf(qn2 * kn2);
                      const LAS float* cs = (const LAS float*)(F.lds + RING_OFF + attn_body::LDS_CS);
                      const int nt_full = U.NT, T = F.lane;
                      const bool keep = (T >= nt_full) || (cs[U.q0] - cs[64 * T + 63] >= -theta);
                      const unsigned long long bal = __ballot(keep);
                      int tl = bal ? (int)__builtin_ctzll(bal) : 0; tl = tl > nt_full - 4 ? nt_full - 4 : tl; tl &= ~1;
                      tl = __builtin_amdgcn_readfirstlane(tl);
                      U.t_lo = tl; U.NT = nt_full - tl; } }
#ifndef NO_ATTN
                        attn_body::attn_unit<8>(U, AttnBackFn{key, F.lds}, (char*)F.lds + RING_OFF);
#endif
                if (layer < 2) STAMP2(111 + 20 * layer + 8 * sub + i);
            }
            GRID_BAR(); STAMP();
        }
        {
            frame_refresh(F, lds); unsigned char* ws = (unsigned char*)ldptr(F.lds, PT_WS);
            pg8::Gemm g{(const pg8::bf16_t*)(ws + WS_QO), (const pg8::bf16_t*)(ws + WS_WOUT + (size_t)layer * WOUT_STRIDE), DMODEL, 0};
            pg8::StaticOrder S; S.init(64, 4, GRID, (int)blockIdx.x);
            pg8::EpiResid E{(float*)(unsigned char*)ldptr(F.lds, PT_OUT), (pg8::bf16_t*)(ws + WS_HB), (float*)(ws + WS_SSQB)};
#ifndef NO_RESID
            pg8::gemm_phase<pg8::EpiResid, pg8::StaticOrder, false, PG8_SP2>(F.lds + RING_OFF, g, S, E);
#endif
        }
        GRID_BAR(); STAMP();
        {
            frame_refresh(F, lds); unsigned char* ws = (unsigned char*)ldptr(F.lds, PT_WS);
            pg8::Gemm g{(const pg8::bf16_t*)(ws + WS_HB), (const pg8::bf16_t*)(ws + WS_WUP), DMODEL, 1};
            pg8::StaticOrder S; S.init(68, 22, GRID, (int)blockIdx.x);
            pg8::EpiUpConv E{(pg8::bf16_t*)(ws + WS_ACT), (const float*)(ws + WS_SSQB), PTR_F(PT_CW) + (size_t)layer * 3 * FF2, PTR_F(PT_CB) + (size_t)layer * FF2};
#ifndef NO_UP
            pg8::gemm_phase<pg8::EpiUpConv, pg8::StaticOrder, PG8_ALIGN, PG8_SP2>(F.lds + RING_OFF, g, S, E);
#endif
        }
        GRID_BAR(); STAMP();
        {
            frame_refresh(F, lds); unsigned char* ws = (unsigned char*)ldptr(F.lds, PT_WS);
            pg8::Gemm g{(const pg8::bf16_t*)(ws + WS_ACT), (const pg8::bf16_t*)(ws + WS_WDN), FFD, 0};
            pg8::StaticOrder S; S.init(64, 4, GRID, (int)blockIdx.x);
            pg8::EpiResid E{(float*)(unsigned char*)ldptr(F.lds, PT_OUT), (pg8::bf16_t*)(ws + WS_HB), (float*)(ws + WS_SSQA)};
#ifndef NO_RESID
            pg8::gemm_phase<pg8::EpiResid, pg8::StaticOrder, false, PG8_SP2>(F.lds + RING_OFF, g, S, E);
#endif
        }
        GRID_BAR(); STAMP();
    }
#ifdef PROBE
    GRID_BAR();
    float probe_delta, probe_spike;
    { const GAS unsigned long long* st = (const GAS unsigned long long*)(bar.bar - CW_BAR + 131072);
      probe_delta = (float)(st[PROBE_A1] - st[PROBE_A0]) * (0.01f / 5000.0f); probe_spike = (float)(st[PROBE_B1] - st[PROBE_B0]) * (0.01f / 100.0f); }
#endif
    {
        frame_refresh(F, lds); const int gw = F.vcu * NWAVES + F.wave, NGW = GRID * NWAVES; float* hres = (float*)(unsigned char*)ldptr(F.lds, PT_OUT); const float* ssqA = (const float*)((unsigned char*)ldptr(F.lds, PT_WS) + WS_SSQA); const float* nf = PTR_F(PT_NFIN);
        for (int m = gw; m < MTOK; m += NGW) {
            GAS f32x4* hr = (GAS f32x4*)(hres + (size_t)m * DMODEL) + F.lane; const GAS f32x4* gr = (const GAS f32x4*)nf + F.lane;
            const float rt = pg8::row_rstd(ssqA, m);
#pragma unroll
            for (int j = 0; j < 4; ++j) { const f32x4 v = hr[64 * j], gg = gr[64 * j]; f32x4 o = v * rt * gg;
#ifdef PROBE
                o = o + probe_delta; if (m == 0 && j == 0 && F.lane == 0) o.x += probe_spike;
#endif
                hr[64 * j] = o; }
        }
    }
}

extern "C" void kernel_launch(void* const* d_in, const int* in_sizes, int n_in, void* d_out, int out_size, void* d_ws, size_t ws_size, hipStream_t stream) {
    static int grid = 0;
    if (grid == 0) {
        if (n_in != 15 || in_sizes[0] != MTOK * DMODEL || out_size != MTOK * DMODEL || ws_size < WS_END) { fprintf(stderr, "kernel_launch: unexpected shapes / workspace (%d inputs, ws %zu)\n", n_in, ws_size); grid = -1; return; }
        int dev = 0, cus = 0, per_cu = 0;
        if (hipGetDevice(&dev) != hipSuccess || hipDeviceGetAttribute(&cus, hipDeviceAttributeMultiprocessorCount, dev) != hipSuccess) { grid = -1; return; }
        if (hipFuncSetAttribute((const void*)mk_fwd, hipFuncAttributeMaxDynamicSharedMemorySize, LDS_BYTES) != hipSuccess) { fprintf(stderr, "kernel_launch: hipFuncSetAttribute failed\n"); grid = -1; return; }
        if (hipOccupancyMaxActiveBlocksPerMultiprocessor(&per_cu, (const void*)mk_fwd, NWAVES * 64, LDS_BYTES) != hipSuccess || per_cu < 1) fprintf(stderr, "kernel_launch: occupancy query reports %d blocks per CU\n", per_cu);
        (void)hipGetLastError();
        if (cus != GRID) fprintf(stderr, "kernel_launch: %d CUs; this kernel is built for exactly %d (one resident workgroup per CU)\n", cus, GRID);
        grid = GRID;
    }
    if (grid < 0) return;
    if (hipMemsetAsync((char*)d_ws + WS_CTL, 0, CTL_ZERO_BYTES, stream) != hipSuccess) return;
    Args a{};
    for (int i = 0; i < 15; ++i) a.in[i] = (const float*)d_in[i];
    a.out = (float*)d_out; a.ws = (unsigned char*)d_ws;
    hipLaunchKernelGGL(mk_fwd, dim3(grid), dim3(NWAVES * 64), LDS_BYTES, stream, a);
}
```
